# Optimizing an MI355X kernel written in HIP

```python
import math
import jax, jax.numpy as jnp
from jax import lax
import numpy as np

D_MODEL = 2048
BATCH = 4
SEQ = 8192
DEPTH = 4

N_MIXERS = 2
N_MLSTM = (DEPTH + 1) // 2
N_FOX = DEPTH // 2
MLSTM_HEADS = 4
MLSTM_DQK = D_MODEL // (2 * MLSTM_HEADS)
MLSTM_DV = D_MODEL // MLSTM_HEADS
MLSTM_QK = MLSTM_HEADS * MLSTM_DQK
MLSTM_V = MLSTM_HEADS * MLSTM_DV
MLSTM_IN = 2 * MLSTM_QK + 2 * MLSTM_V + 2 * MLSTM_HEADS
MLSTM_CHUNK = 64
GATE_SOFTCAP = 15.0
FOX_HEAD_DIM = 128
FOX_HEADS = D_MODEL // FOX_HEAD_DIM
FOX_IN = 3 * D_MODEL + FOX_HEADS
Q_BLOCK = 128
FFN_MULT = 256
D_FF = ((8 * D_MODEL + 3 * FFN_MULT - 1) // (3 * FFN_MULT)) * FFN_MULT
EPS = 1e-6

kernel_name = "hybrid_mlstm_fox_adaln_trunk"


def rms_norm(x, w):
    xf = x.astype(jnp.float32)
    y = xf * lax.rsqrt(jnp.mean(xf * xf, axis=-1, keepdims=True) + EPS)
    return (y * w.astype(jnp.float32)).astype(x.dtype)


def mlstm_chunkwise(q, k, v, log_i, log_f):
    B, H, T, dqk = q.shape
    dv = v.shape[-1]
    L = MLSTM_CHUNK
    nc = T // L

    def to_chunks(a):
        a = a.reshape((B, H, nc, L) + a.shape[3:])
        return jnp.moveaxis(a, 2, 0)

    causal = jnp.arange(L)[:, None] >= jnp.arange(L)[None, :]

    def step(carry, inp):
        C, n, m = carry
        qc, kc, vc, lic, lfc = inp
        b = jnp.cumsum(lfc, axis=-1)
        g = b[..., -1]
        D = b[..., :, None] - b[..., None, :] + lic[..., None, :]
        D = jnp.where(causal, D, -jnp.inf)
        inter_log = b + m[..., None]
        m_t = jnp.maximum(inter_log, jnp.max(D, axis=-1))
        w_intra = jnp.exp(D - m_t[..., None])
        w_inter = jnp.exp(inter_log - m_t)
        s = jnp.einsum('bhtd,bhsd->bhts', qc, kc) * w_intra
        num = w_inter[..., None] * jnp.einsum('bhtd,bhde->bhte', qc, C) + jnp.einsum('bhts,bhse->bhte', s, vc)
        den = w_inter * jnp.einsum('bhtd,bhd->bht', qc, n) + jnp.sum(s, axis=-1)
        h = num / jnp.maximum(jnp.abs(den), jnp.exp(-m_t))[..., None]
        tail = g[..., None] - b + lic
        m_new = jnp.maximum(g + m, jnp.max(tail, axis=-1))
        w_tail = jnp.exp(tail - m_new[..., None])
        decay = jnp.exp(g + m - m_new)
        C_new = decay[..., None, None] * C + jnp.einsum('bhs,bhsd,bhse->bhde', w_tail, kc, vc)
        n_new = decay[..., None] * n + jnp.einsum('bhs,bhsd->bhd', w_tail, kc)
        return (C_new, n_new, m_new), h

    init = (jnp.zeros((B, H, dqk, dv), jnp.float32),
            jnp.zeros((B, H, dqk), jnp.float32),
            jnp.zeros((B, H), jnp.float32))
    _, hs = lax.scan(step, init, (to_chunks(q), to_chunks(k), to_chunks(v), to_chunks(log_i), to_chunks(log_f)))
    return jnp.moveaxis(hs, 0, 2).reshape(B, H, T, dv)


def mlstm_mixer(h, w_in, b_gates, norm_w, w_out):
    B, T, _ = h.shape
    Hh = MLSTM_HEADS
    proj = h @ w_in
    q, k, v, o, gates = jnp.split(proj, [MLSTM_QK, 2 * MLSTM_QK, 2 * MLSTM_QK + MLSTM_V, 2 * MLSTM_QK + 2 * MLSTM_V], axis=-1)
    heads = lambda a, d: a.astype(jnp.float32).reshape(B, T, Hh, d).transpose(0, 2, 1, 3)
    q = heads(q, MLSTM_DQK) * (MLSTM_DQK ** -0.5)
    k = heads(k, MLSTM_DQK)
    v = heads(v, MLSTM_DV)
    gates = gates.astype(jnp.float32) + b_gates.astype(jnp.float32)
    gates = GATE_SOFTCAP * jnp.tanh(gates / GATE_SOFTCAP)
    log_i = gates[..., :Hh].transpose(0, 2, 1)
    log_f = jax.nn.log_sigmoid(gates[..., Hh:]).transpose(0, 2, 1)
    hs = mlstm_chunkwise(q, k, v, log_i, log_f)
    hs = hs * lax.rsqrt(jnp.mean(hs * hs, axis=-1, keepdims=True) + EPS)
    hs = hs.transpose(0, 2, 1, 3).reshape(B, T, MLSTM_V) * norm_w.astype(jnp.float32)
    y = jax.nn.sigmoid(o.astype(jnp.float32)) * hs
    return y.astype(h.dtype) @ w_out


def forgetting_attention(q, k, v, log_f):
    B, H, T, dh = q.shape
    nb = T // Q_BLOCK
    cum = jnp.cumsum(log_f, axis=-1)
    kf = k.astype(jnp.float32)
    vf = v.astype(jnp.float32)
    qb = jnp.moveaxis(q.astype(jnp.float32).reshape(B, H, nb, Q_BLOCK, dh), 2, 0)
    cqb = jnp.moveaxis(cum.reshape(B, H, nb, Q_BLOCK), 2, 0)
    kpos = jnp.arange(T)
    scale = dh ** -0.5

    def block(args):
        qi, cqi, bi = args
        s = jnp.einsum('bhqd,bhkd->bhqk', qi, kf) * scale + cqi[..., None] - cum[..., None, :]
        qpos = bi * Q_BLOCK + jnp.arange(Q_BLOCK)
        s = jnp.where(kpos[None, :] <= qpos[:, None], s, -jnp.inf)
        p = jax.nn.softmax(s, axis=-1)
        return jnp.einsum('bhqk,bhkd->bhqd', p, vf)

    out = lax.map(block, (qb, cqb, jnp.arange(nb)))
    return jnp.moveaxis(out, 0, 2).reshape(B, H, T, dh)


def fox_mixer(h, w_in, b_f, w_out):
    B, T, _ = h.shape
    Hh = FOX_HEADS
    proj = h @ w_in
    q, k, v, fl = jnp.split(proj, [D_MODEL, 2 * D_MODEL, 3 * D_MODEL], axis=-1)
    heads = lambda a: a.reshape(B, T, Hh, FOX_HEAD_DIM).transpose(0, 2, 1, 3)
    log_f = jax.nn.log_sigmoid(fl.astype(jnp.float32) + b_f.astype(jnp.float32)).transpose(0, 2, 1)
    o = forgetting_attention(heads(q), heads(k), heads(v), log_f)
    o = o.transpose(0, 2, 1, 3).reshape(B, T, D_MODEL).astype(h.dtype)
    return o @ w_out


def swiglu(h, w_gate_up, w_down):
    g, u = jnp.split(h @ w_gate_up, 2, axis=-1)
    return (jax.nn.silu(g) * u) @ w_down


def setup_inputs(seed: int = 0) -> dict:
    key = jax.random.key(seed)
    ks = jax.random.split(key, 20)
    f32 = jnp.float32
    nrm = lambda k, shape, s: jax.random.normal(k, shape, f32) * s
    x = nrm(ks[0], (BATCH, SEQ, D_MODEL), 1.0)
    c = nrm(ks[1], (BATCH, D_MODEL), 1.0)
    ada_w = nrm(ks[2], (DEPTH, D_MODEL, 6 * D_MODEL), 0.5 * D_MODEL ** -0.5)
    ada_b = nrm(ks[3], (DEPTH, 6 * D_MODEL), 0.02)
    norm_mix_w = 1.0 + nrm(ks[4], (DEPTH, D_MODEL), 0.05)
    norm_ffn_w = 1.0 + nrm(ks[5], (DEPTH, D_MODEL), 0.05)
    mlstm_w_in = nrm(ks[6], (N_MLSTM, D_MODEL, MLSTM_IN), D_MODEL ** -0.5)
    b_i = nrm(ks[7], (N_MLSTM, MLSTM_HEADS), 0.1)
    b_f = jnp.linspace(3.0, 6.0, MLSTM_HEADS, dtype=f32)[None, :] + nrm(ks[8], (N_MLSTM, MLSTM_HEADS), 0.1)
    mlstm_b_gates = jnp.concatenate([b_i, b_f], axis=-1)
    mlstm_norm_w = 1.0 + nrm(ks[9], (N_MLSTM, MLSTM_V), 0.05)
    mlstm_w_out = nrm(ks[10], (N_MLSTM, MLSTM_V, D_MODEL), MLSTM_V ** -0.5)
    fox_w_in = nrm(ks[11], (N_FOX, D_MODEL, FOX_IN), D_MODEL ** -0.5)
    fox_b_f = 4.0 + nrm(ks[12], (N_FOX, FOX_HEADS), 0.5)
    fox_w_out = nrm(ks[13], (N_FOX, D_MODEL, D_MODEL), D_MODEL ** -0.5)
    ffn_w_gate_up = nrm(ks[14], (DEPTH, D_MODEL, 2 * D_FF), D_MODEL ** -0.5)
    ffn_w_down = nrm(ks[15], (DEPTH, D_FF, D_MODEL), D_FF ** -0.5)
    final_norm_w = 1.0 + nrm(ks[16], (D_MODEL,), 0.05)
    return {"x": x, "c": c, "ada_w": ada_w, "ada_b": ada_b,
            "norm_mix_w": norm_mix_w, "norm_ffn_w": norm_ffn_w,
            "mlstm_w_in": mlstm_w_in, "mlstm_b_gates": mlstm_b_gates,
            "mlstm_norm_w": mlstm_norm_w, "mlstm_w_out": mlstm_w_out,
            "fox_w_in": fox_w_in, "fox_b_f": fox_b_f, "fox_w_out": fox_w_out,
            "ffn_w_gate_up": ffn_w_gate_up, "ffn_w_down": ffn_w_down,
            "final_norm_w": final_norm_w}


def reference(x, c, ada_w, ada_b, norm_mix_w, norm_ffn_w, mlstm_w_in, mlstm_b_gates,
              mlstm_norm_w, mlstm_w_out, fox_w_in, fox_b_f, fox_w_out,
              ffn_w_gate_up, ffn_w_down, final_norm_w):
    cs = jax.nn.silu(c)
    for layer in range(DEPTH):
        mod = cs @ ada_w[layer] + ada_b[layer]
        sh1, sc1, g1, sh2, sc2, g2 = [m[:, None, :] for m in jnp.split(mod, 6, axis=-1)]
        h = rms_norm(x, norm_mix_w[layer]) * (1.0 + sc1) + sh1
        j = layer // N_MIXERS
        if layer % N_MIXERS == 0:
            y = mlstm_mixer(h, mlstm_w_in[j], mlstm_b_gates[j], mlstm_norm_w[j], mlstm_w_out[j])
        else:
            y = fox_mixer(h, fox_w_in[j], fox_b_f[j], fox_w_out[j])
        x = x + g1 * y
        h = rms_norm(x, norm_ffn_w[layer]) * (1.0 + sc2) + sh2
        x = x + g2 * swiglu(h, ffn_w_gate_up[layer], ffn_w_down[layer])
    return rms_norm(x, final_norm_w)
```

```cpp
#include <hip/hip_runtime.h>
#include <hip/hip_bf16.h>
#include <cstdio>
#include <cstdint>
#include <cstddef>
namespace pg8 {
#define PG8_LAS __attribute__((address_space(3)))
typedef unsigned short bf16_t;
typedef short bf16x8 __attribute__((ext_vector_type(8)));
typedef float f32x4 __attribute__((ext_vector_type(4)));
typedef float f32x2 __attribute__((ext_vector_type(2)));
typedef unsigned u32x4 __attribute__((ext_vector_type(4)));
constexpr int BM = 256, BK = 64, HALF = 128, HTB = HALF * BK * 2  , STAGE_BYTES = 8 * HTB, NXCD = 8, WGM = 4;

__host__ __device__ __forceinline__ int lds_byte(int r, int c) { const int st = (r >> 4) * 2 + (c >> 5), rr = r & 15, cc = c & 31, ob = rr * 64 + cc * 2; return st * 1024 + (ob ^ (((ob >> 9) & 1) << 5)); }
__host__ __device__ __forceinline__ void stage_rc(int b, int& R, int& C) { const int st = b / 1024, sb = b % 1024, swz = sb ^ (((sb >> 9) & 1) << 5); R = (st >> 1) * 16 + swz / 64; C = (st & 1) * 32 + (swz % 64) / 2; }
__host__ __device__ __forceinline__ int perm32(int rho) { const int n = rho >> 4, i = rho & 15; return 8 * (i >> 2) + 4 * n + (i & 3); }

struct Unit { const char* A; const char* B; const char* A1; const char* B1; char* O; int pm, pn; };
struct Gemm { unsigned lda, ldb, lda1, ldb1; int K, nt0; };

struct TileOrder {
    int nM, nN, nwg, G, c, wgm, rev;
    __device__ void init(int M, int N, int G_, int c_, int wgm_ = WGM, int rev_ = 0) { nM = M / BM; nN = N / BM; nwg = nM * nN; G = G_; c = c_; wgm = wgm_; rev = rev_; }
    __device__ bool tile(int i, int& pm, int& pn) const {
        const long L = (long)i * G + c; if (L >= nwg) return false;
        int wgid = (int)L; { const int q = nwg / NXCD, r = nwg % NXCD, xcd = wgid % NXCD, off = wgid / NXCD; wgid = (xcd < r ? xcd * (q + 1) : r * (q + 1) + (xcd - r) * q) + off; }
        if (rev) { const int q = nwg / NXCD, x = wgid / q; wgid = x * q + (q - 1 - (wgid - x * q)); }
        const int nig = wgm * nN, gid = wgid / nig, fm = gid * wgm, gsz = (nM - fm) < wgm ? (nM - fm) : wgm;
        pm = fm + ((wgid % nig) % gsz); pn = (wgid % nig) / gsz; return true;
    }
};

__device__ __forceinline__ unsigned cvt_pk_bf16(float lo, float hi) { unsigned r; asm volatile("v_cvt_pk_bf16_f32 %0, %1, %2" : "=v"(r) : "v"(lo), "v"(hi)); return r; }


template <class Epi, class Sched, bool ALIGN_EPI = false, bool SP2 = true, bool SPLIT = false>
__device__ __forceinline__ void gemm_phase(PG8_LAS unsigned char* lds, const Gemm g, const Sched& S, const Epi& E, const int tid  ) {
    const int wid = __builtin_amdgcn_readfirstlane(tid >> 6), lane = tid & 63, wr = wid >> 2, wc = wid & 3, fr = lane & 15, fq = lane >> 4;
    const int K = g.K, nt = K / BK;
    unsigned voffA[2], voffB[2], voffA1[2], voffB1[2];
#pragma unroll
    for (int i = 0; i < 2; ++i) { int R, C; stage_rc(tid * 16 + i * 8192, R, C); const int Rb = Epi::PERM ? ((R & ~31) + perm32(R & 31)) : R;
        voffA[i] = (unsigned)R * g.lda + (unsigned)C * 2u; voffB[i] = (unsigned)Rb * g.ldb + (unsigned)C * 2u;
        voffA1[i] = SPLIT ? (unsigned)R * g.lda1 + (unsigned)C * 2u : 0u; voffB1[i] = SPLIT ? (unsigned)Rb * g.ldb1 + (unsigned)C * 2u : 0u; }
    const size_t kstep = (size_t)(BK * 2);
    const unsigned hstepA = (unsigned)HALF * g.lda, hstepB = (unsigned)HALF * g.ldb;
    const unsigned hstepA1 = SPLIT ? (unsigned)HALF * g.lda1 : 0u, hstepB1 = SPLIT ? (unsigned)HALF * g.ldb1 : 0u;
    const unsigned ldsw = (unsigned)wid * 1024u;
    const int aoff = lds_byte(wr * 64 + fr, fq * 8), boff = lds_byte(wc * 32 + fr, fq * 8);
#define PG8_SA(b, h) (((b) * 2 + (h)) * HTB)
#define PG8_SB(b, h) ((4 + (b) * 2 + (h)) * HTB)
#define PG8_STAGE(bufoff, gbase, v0, v1) do { \
        __builtin_amdgcn_global_load_lds((const unsigned*)((const char*)(gbase) + (v0)), (PG8_LAS unsigned*)(lds + (bufoff) + ldsw), 16, 0, 0); \
        __builtin_amdgcn_global_load_lds((const unsigned*)((const char*)(gbase) + (v1)), (PG8_LAS unsigned*)(lds + (bufoff) + ldsw + 8192), 16, 0, 0); } while (0)
#define PG8_LDA(dst, b, h) do { _Pragma("unroll") for (int m = 0; m < 4; ++m) _Pragma("unroll") for (int k = 0; k < 2; ++k) dst[m][k] = *(const PG8_LAS bf16x8*)(lds + PG8_SA(b, h) + aoff + m * 2048 + k * 1024); } while (0)
#define PG8_LDB(dst, b, h) do { _Pragma("unroll") for (int n = 0; n < 2; ++n) _Pragma("unroll") for (int k = 0; k < 2; ++k) dst[n][k] = *(const PG8_LAS bf16x8*)(lds + PG8_SB(b, h) + boff + n * 2048 + k * 1024); } while (0)
#define PG8_MMA(ai, bj, At, Bt) do { __builtin_amdgcn_s_setprio(1); _Pragma("unroll") for (int m = 0; m < 4; ++m) _Pragma("unroll") for (int n = 0; n < 2; ++n) _Pragma("unroll") for (int k = 0; k < 2; ++k) \
        acc[ai][bj][m][n] = __builtin_amdgcn_mfma_f32_16x16x32_bf16(Bt[n][k], At[m][k], acc[ai][bj][m][n], 0, 0, 0); __builtin_amdgcn_s_setprio(0); } while (0)
#define PG8_WAIT_V(n) asm volatile("s_waitcnt vmcnt(" #n ")" ::: "memory")
#define PG8_WAIT_L(n) asm volatile("s_waitcnt lgkmcnt(" #n ")" ::: "memory")
#define PG8_BAR __builtin_amdgcn_s_barrier()
#define PG8_SCHED __builtin_amdgcn_sched_barrier(0)
    Unit cur, nxt; int ui = 0;
    if (!S.next(0, cur)) return;
    f32x4 acc[2][2][4][2];
#pragma unroll
    for (int a = 0; a < 2; ++a)
#pragma unroll
        for (int b = 0; b < 2; ++b)
#pragma unroll
            for (int m = 0; m < 4; ++m)
#pragma unroll
                for (int n = 0; n < 2; ++n) acc[a][b][m][n] = (f32x4){0.f, 0.f, 0.f, 0.f};
    bf16x8 At[4][2], B0[2][2], B1[2][2];
    const char* cA = cur.A; const char* cB = cur.B; const char* cA1 = SPLIT ? cur.A1 : nullptr; const char* cB1 = SPLIT ? cur.B1 : nullptr;
    if constexpr (SP2) {
        PG8_STAGE(PG8_SB(0, 0), cB, voffB[0], voffB[1]); PG8_STAGE(PG8_SB(0, 1), cB + hstepB, voffB[0], voffB[1]); PG8_STAGE(PG8_SA(0, 0), cA, voffA[0], voffA[1]); PG8_STAGE(PG8_SA(0, 1), cA + hstepA, voffA[0], voffA[1]);
        if (wr == 1) PG8_BAR;
        PG8_WAIT_V(2); PG8_BAR;
        PG8_STAGE(PG8_SB(1, 0), cB + kstep, voffB[0], voffB[1]); PG8_STAGE(PG8_SA(1, 0), cA + kstep, voffA[0], voffA[1]); PG8_STAGE(PG8_SB(1, 1), cB + hstepB + kstep, voffB[0], voffB[1]);
        PG8_WAIT_V(6); PG8_BAR;
    } else {
        PG8_STAGE(PG8_SB(0, 0), cB, voffB[0], voffB[1]); PG8_STAGE(PG8_SA(0, 0), cA, voffA[0], voffA[1]); PG8_STAGE(PG8_SB(0, 1), cB + hstepB, voffB[0], voffB[1]); PG8_STAGE(PG8_SA(0, 1), cA + hstepA, voffA[0], voffA[1]);
        if (wr == 1) PG8_BAR;
        PG8_WAIT_V(4); PG8_BAR;
        PG8_STAGE(PG8_SB(1, 0), cB + kstep, voffB[0], voffB[1]); PG8_STAGE(PG8_SA(1, 0), cA + kstep, voffA[0], voffA[1]); PG8_STAGE(PG8_SB(1, 1), cB + hstepB + kstep, voffB[0], voffB[1]);
        PG8_WAIT_V(6); PG8_BAR;
    }
    for (;;) {
        const bool has_next = S.next(ui + 1, nxt);
        const char* nA = has_next ? nxt.A : cA; const char* nB = has_next ? nxt.B : cB;
#pragma unroll 1
        for (int t = 0; t < nt; t += 2) {
            const bool last = (t == nt - 2);
            const char *a1, *a2, *b2; unsigned hA1, hA2, hB2; unsigned vA1_0, vA1_1, vA2_0, vA2_1, vB2_0, vB2_1;
            if constexpr (SPLIT) {
                const bool s1 = (t + 1) < g.nt0, s2 = last || (t + 2) < g.nt0;
                a1 = s1 ? cA + (size_t)(t + 1) * kstep : cA1 + (size_t)(t + 1 - g.nt0) * kstep; hA1 = s1 ? hstepA : hstepA1; vA1_0 = s1 ? voffA[0] : voffA1[0]; vA1_1 = s1 ? voffA[1] : voffA1[1];
                a2 = last ? nA : (s2 ? cA + (size_t)(t + 2) * kstep : cA1 + (size_t)(t + 2 - g.nt0) * kstep);
                b2 = last ? nB : (s2 ? cB + (size_t)(t + 2) * kstep : cB1 + (size_t)(t + 2 - g.nt0) * kstep);
                hA2 = s2 ? hstepA : hstepA1; hB2 = s2 ? hstepB : hstepB1;
                vA2_0 = s2 ? voffA[0] : voffA1[0]; vA2_1 = s2 ? voffA[1] : voffA1[1]; vB2_0 = s2 ? voffB[0] : voffB1[0]; vB2_1 = s2 ? voffB[1] : voffB1[1];
                if (t == g.nt0) { int le = lane; asm volatile("" : "+v"(le)); E.mid(acc, cur, wr, wc, le & 15, le >> 4, nullptr); }
            } else {
                a1 = cA + (size_t)(t + 1) * kstep; hA1 = hstepA; vA1_0 = voffA[0]; vA1_1 = voffA[1];
                a2 = last ? nA : cA + (size_t)(t + 2) * kstep; b2 = last ? nB : cB + (size_t)(t + 2) * kstep; hA2 = hstepA; hB2 = hstepB;
                vA2_0 = voffA[0]; vA2_1 = voffA[1]; vB2_0 = voffB[0]; vB2_1 = voffB[1];
            }
            const char* a3 = a2 + kstep; const char* b3 = b2 + kstep;
            if constexpr (SP2) {
            PG8_LDB(B0, 0, 0); PG8_LDB(B1, 0, 1); PG8_SCHED; PG8_LDA(At, 0, 0); PG8_STAGE(PG8_SA(1, 1), a1 + hA1, vA1_0, vA1_1);
            PG8_WAIT_V(8); PG8_WAIT_L(0); PG8_BAR; PG8_MMA(0, 0, At, B0); PG8_MMA(0, 1, At, B1); PG8_BAR; PG8_SCHED;
            PG8_LDA(At, 0, 1); PG8_STAGE(PG8_SB(0, 0), b2, vB2_0, vB2_1); PG8_STAGE(PG8_SB(0, 1), b2 + hB2, vB2_0, vB2_1); PG8_STAGE(PG8_SA(0, 0), a2, vA2_0, vA2_1);
            PG8_WAIT_V(8); PG8_WAIT_L(0); PG8_BAR; PG8_MMA(1, 0, At, B0); PG8_MMA(1, 1, At, B1); PG8_BAR; PG8_SCHED;
            PG8_LDB(B0, 1, 0); PG8_LDB(B1, 1, 1); PG8_SCHED; PG8_LDA(At, 1, 0); PG8_STAGE(PG8_SA(0, 1), a2 + hA2, vA2_0, vA2_1);
            PG8_WAIT_V(8); PG8_WAIT_L(0); PG8_BAR; PG8_MMA(0, 0, At, B0); PG8_MMA(0, 1, At, B1); PG8_BAR; PG8_SCHED;
            PG8_LDA(At, 1, 1); PG8_STAGE(PG8_SB(1, 0), b3, vB2_0, vB2_1); PG8_STAGE(PG8_SB(1, 1), b3 + hB2, vB2_0, vB2_1); PG8_STAGE(PG8_SA(1, 0), a3, vA2_0, vA2_1);
            PG8_WAIT_V(8); PG8_WAIT_L(0); PG8_BAR; PG8_MMA(1, 0, At, B0); PG8_MMA(1, 1, At, B1); PG8_BAR; PG8_SCHED;
            } else {
            PG8_LDB(B0, 0, 0); PG8_SCHED; PG8_LDA(At, 0, 0); PG8_STAGE(PG8_SA(1, 1), a1 + hA1, vA1_0, vA1_1);
            PG8_WAIT_L(8); PG8_BAR; PG8_WAIT_L(0); PG8_MMA(0, 0, At, B0); PG8_BAR; PG8_SCHED;
            PG8_LDB(B1, 0, 1); PG8_STAGE(PG8_SB(0, 0), b2, vB2_0, vB2_1);
            PG8_BAR; PG8_WAIT_L(0); PG8_MMA(0, 1, At, B1); PG8_BAR;
            PG8_LDA(At, 0, 1); PG8_STAGE(PG8_SA(0, 0), a2, vA2_0, vA2_1);
            PG8_BAR; PG8_WAIT_L(0); PG8_MMA(1, 0, At, B0); PG8_BAR; PG8_SCHED;
            PG8_STAGE(PG8_SB(0, 1), b2 + hB2, vB2_0, vB2_1);
            PG8_WAIT_V(6); PG8_BAR; PG8_MMA(1, 1, At, B1); PG8_BAR;
            PG8_LDB(B0, 1, 0); PG8_SCHED; PG8_LDA(At, 1, 0); PG8_STAGE(PG8_SA(0, 1), a2 + hA2, vA2_0, vA2_1);
            PG8_WAIT_L(8); PG8_BAR; PG8_WAIT_L(0); PG8_MMA(0, 0, At, B0); PG8_BAR; PG8_SCHED;
            PG8_LDB(B1, 1, 1); PG8_STAGE(PG8_SB(1, 0), b3, vB2_0, vB2_1);
            PG8_BAR; PG8_WAIT_L(0); PG8_MMA(0, 1, At, B1); PG8_BAR;
            PG8_LDA(At, 1, 1); PG8_STAGE(PG8_SA(1, 0), a3, vA2_0, vA2_1);
            PG8_BAR; PG8_WAIT_L(0); PG8_MMA(1, 0, At, B0); PG8_BAR; PG8_SCHED;
            PG8_STAGE(PG8_SB(1, 1), b3 + hB2, vB2_0, vB2_1);
            PG8_WAIT_V(6); PG8_BAR; PG8_MMA(1, 1, At, B1); PG8_BAR;
            }
        }
        if constexpr (ALIGN_EPI) { if (wr == 0) PG8_BAR; }
        { int le = lane; asm volatile("" : "+v"(le)); E(acc, cur, wr, wc, le & 15, le >> 4, lds + PG8_SA(1, 1) + ldsw); }
        if (!has_next) break;
#pragma unroll
        for (int a = 0; a < 2; ++a)
#pragma unroll
            for (int b = 0; b < 2; ++b)
#pragma unroll
                for (int m = 0; m < 4; ++m)
#pragma unroll
                    for (int n = 0; n < 2; ++n) acc[a][b][m][n] = (f32x4){0.f, 0.f, 0.f, 0.f};
        cur = nxt; cA = nA; cB = nB; if constexpr (SPLIT) { cA1 = cur.A1; cB1 = cur.B1; } ++ui;
        if constexpr (ALIGN_EPI) { if (wr == 1) PG8_BAR; }
    }
    PG8_WAIT_V(0);
    if constexpr (!ALIGN_EPI) { if (wr == 0) PG8_BAR; }
    PG8_BAR;
#undef PG8_SA
#undef PG8_SB
#undef PG8_STAGE
#undef PG8_LDA
#undef PG8_LDB
#undef PG8_MMA
#undef PG8_WAIT_V
#undef PG8_WAIT_L
#undef PG8_BAR
#undef PG8_SCHED
}
}
namespace fa {
using bf16 = __hip_bfloat16;
typedef short bf16x8 __attribute__((ext_vector_type(8)));
typedef short s16x4 __attribute__((ext_vector_type(4)));
typedef float f32x16 __attribute__((ext_vector_type(16)));
typedef float f32x4 __attribute__((ext_vector_type(4)));
typedef unsigned u32x4 __attribute__((ext_vector_type(4)));
constexpr int D = 128;
constexpr int QPITCH = 6144, OPITCH = 2048;
constexpr float SCALE = 0.08838834764831845f;
constexpr float THR = 4.f;
constexpr int NW = 8, QBLK = 32, KVBLK = 64, QB = NW * QBLK;
constexpr int SHM_V = KVBLK * D * 2, SHM_K = KVBLK * D * 2;
constexpr int NBUF = 3;
constexpr int BIAS_OFF = NBUF * SHM_V + NBUF * SHM_K + NW * 64 * 4;
constexpr int LDS_BYTES = BIAS_OFF + 8192 * 4;

#define KSWZ(row, colB) ((row) * 256 + ((colB) ^ (((row) & 7) << 4)))
#define SBAR() __builtin_amdgcn_sched_barrier(0)
__device__ __forceinline__ int v_st(int k, int c) { const int kk = (k & ~0xC) | ((k & 4) << 1) | ((k & 8) >> 1); return ((kk >> 3) * 4 + (c >> 5)) * 512 + ((kk & 7) * 32 + (c & 31)) * 2; }
__device__ __forceinline__ int v_rd_base(int lane) { return ((lane & 3) << 3) | (((lane >> 2) & 3) << 6) | (((lane >> 4) & 1) << 5) | (((lane >> 5) & 1) << 8); }
constexpr int v_rd_off(int d0, int ks, int half) { return d0 * 512 + ks * 4096 + half * 2048; }
__device__ __forceinline__ int lane_now() { int t; asm volatile("v_mbcnt_lo_u32_b32 %0, -1, 0\n\tv_mbcnt_hi_u32_b32 %0, -1, %0" : "=v"(t)); return t; }
__device__ __forceinline__ int crow(int r, int hi) { return (r & 3) + 8 * (r >> 2) + 4 * hi; }
__device__ __forceinline__ unsigned cvtpk(float lo, float hi) { unsigned r; asm volatile("v_cvt_pk_bf16_f32 %0, %1, %2" : "=v"(r) : "v"(lo), "v"(hi)); return r; }
__device__ __forceinline__ bf16x8 load8(const bf16* p) { return *reinterpret_cast<const bf16x8*>(p); }
__device__ __forceinline__ void mask_tile(f32x16& p0, f32x16& p1, int dq) {
    const float NEG = -__builtin_inff();
#pragma unroll
    for (int r = 0; r < 16; ++r) {
        const int c = (r & 3) + 8 * (r >> 2);
        if (dq - c < 0) p0[r] = NEG;
        if (dq - c - 32 < 0) p1[r] = NEG;
    }
}
__device__ __forceinline__ bool partialSM(f32x16& p0, f32x16& p1, float& m_reg, float& mn, float& alpha) {
    float pmax = p0[0]; for (int r = 1; r < 16; ++r) pmax = fmaxf(pmax, p0[r]); for (int r = 0; r < 16; ++r) pmax = fmaxf(pmax, p1[r]);
    { auto rr = __builtin_amdgcn_permlane32_swap(__float_as_uint(pmax), __float_as_uint(pmax), false, false);
      pmax = fmaxf(__uint_as_float(rr[0]), __uint_as_float(rr[1])); }
    constexpr float C2 = 1.4426950408889634f * SCALE;
    if (__all((pmax - m_reg) * C2 < -127.f)) { mn = m_reg; alpha = 1.f; return true; }
    if (__builtin_expect(__all((pmax - m_reg) * SCALE <= THR), 1)) { mn = m_reg; alpha = 1.f; }
    else { mn = fmaxf(m_reg, pmax); alpha = __builtin_amdgcn_exp2f((m_reg - mn) * C2); m_reg = mn; }
    const float mnL = -mn * C2;
    for (int r = 0; r < 16; ++r) p0[r] = fmaf(p0[r], C2, mnL); for (int r = 0; r < 16; ++r) p1[r] = fmaf(p1[r], C2, mnL);
    for (int r = 0; r < 16; ++r) p0[r] = __builtin_amdgcn_exp2f(p0[r]);
    return false;
}
__device__ __forceinline__ void finishSM(f32x16& p0, f32x16& p1, float alpha, float& l_reg, bf16x8& pa0, bf16x8& pa1, bf16x8& pa2, bf16x8& pa3, const bool dead = false) {
    for (int r = 0; r < 16; ++r) p1[r] = __builtin_amdgcn_exp2f(p1[r]);
    float ps = 0; for (int r = 0; r < 16; ++r) ps += p0[r]; for (int r = 0; r < 16; ++r) ps += p1[r];
    { auto rr = __builtin_amdgcn_permlane32_swap(__float_as_uint(ps), __float_as_uint(ps), false, false);
      ps = __uint_as_float(rr[0]) + __uint_as_float(rr[1]); }
    l_reg = dead ? l_reg : l_reg * alpha + ps;
#define PK4(P, B_, OUT) do { unsigned a0 = cvtpk(P[B_+0], P[B_+1]), a1 = cvtpk(P[B_+2], P[B_+3]);                          \
        unsigned b0 = cvtpk(P[B_+4], P[B_+5]), b1 = cvtpk(P[B_+6], P[B_+7]);                                             \
        auto r0 = __builtin_amdgcn_permlane32_swap(a0, b0, false, false); auto r1 = __builtin_amdgcn_permlane32_swap(a1, b1, false, false); \
        u32x4 w = {r0[0], r1[0], r0[1], r1[1]}; OUT = *reinterpret_cast<bf16x8*>(&w); } while (0)
    PK4(p0, 0, pa0); PK4(p0, 8, pa1); PK4(p1, 0, pa2); PK4(p1, 8, pa3);
#undef PK4
}
__device__ __forceinline__ void qkt(int KB, f32x16& p0, f32x16& p1, const char* K_lds, int r32, int hi, const bf16x8* qr, const char* bias_t) {
    { const int ln_ = lane_now(); bias_t += ((ln_ >> 5) << 4);
#pragma unroll
      for (int g4 = 0; g4 < 4; ++g4) { const f32x4 b0 = *reinterpret_cast<const f32x4*>(bias_t + g4 * 32); const f32x4 b1 = *reinterpret_cast<const f32x4*>(bias_t + 128 + g4 * 32);
        p0[4 * g4 + 0] = b0[0]; p0[4 * g4 + 1] = b0[1]; p0[4 * g4 + 2] = b0[2]; p0[4 * g4 + 3] = b0[3];
        p1[4 * g4 + 0] = b1[0]; p1[4 * g4 + 1] = b1[1]; p1[4 * g4 + 2] = b1[2]; p1[4 * g4 + 3] = b1[3]; } }
    unsigned k0a = (unsigned)(uintptr_t)K_lds + (unsigned)(KB * SHM_K) + (unsigned)KSWZ(r32, hi * 16);
    asm volatile("" : "+v"(k0a));
    const char* kb[4];
#pragma unroll
    for (int dd = 0; dd < 4; ++dd) kb[dd] = (const char*)(__attribute__((address_space(3))) const char*)(uintptr_t)(k0a ^ (unsigned)(dd << 5));
#pragma unroll
    for (int d0 = 0; d0 < 8; ++d0) { const char* a = kb[d0 & 3] + (d0 >> 2) * 128;
        bf16x8 b0 = *reinterpret_cast<const bf16x8*>(a);
        bf16x8 b1 = *reinterpret_cast<const bf16x8*>(a + 32 * 256);
        p0 = __builtin_amdgcn_mfma_f32_32x32x16_bf16(b0, qr[d0], p0, 0, 0, 0);
        p1 = __builtin_amdgcn_mfma_f32_32x32x16_bf16(b1, qr[d0], p1, 0, 0, 0); }
}
__device__ __forceinline__ void add_bias(f32x16& p0, f32x16& p1, const char* bias_t) {
#pragma unroll
    for (int g4 = 0; g4 < 4; ++g4) { const f32x4 b0 = *reinterpret_cast<const f32x4*>(bias_t + g4 * 32);
        p0[4 * g4 + 0] += b0[0]; p0[4 * g4 + 1] += b0[1]; p0[4 * g4 + 2] += b0[2]; p0[4 * g4 + 3] += b0[3]; }
#pragma unroll
    for (int g4 = 0; g4 < 4; ++g4) { const f32x4 b1 = *reinterpret_cast<const f32x4*>(bias_t + 128 + g4 * 32);
        p1[4 * g4 + 0] += b1[0]; p1[4 * g4 + 1] += b1[1]; p1[4 * g4 + 2] += b1[2]; p1[4 * g4 + 3] += b1[3]; }
}
__device__ __forceinline__ void pv_tile(int VB, f32x16* o, int vb0, bf16x8 pa0, bf16x8 pa1, bf16x8 pa2, bf16x8 pa3) {
    const int vbt = vb0 + VB * SHM_V;
#define TRRD(dst, off) asm volatile("ds_read_b64_tr_b16 %0, %1 offset:%2" : "=&v"(dst) : "v"(vbt), "i"(off) : "memory")
#define PV_D0(d0) do { s16x4 l0, l1, l2, l3, h0, h1, h2, h3; constexpr int b_ = v_rd_off(d0, 0, 0);     \
        TRRD(l0, b_); TRRD(h0, b_ + 2048); TRRD(l1, b_ + 4096); TRRD(h1, b_ + 6144); TRRD(l2, b_ + 8192); TRRD(h2, b_ + 10240); TRRD(l3, b_ + 12288); TRRD(h3, b_ + 14336); \
        asm volatile("s_waitcnt lgkmcnt(0)" ::: "memory"); SBAR();   \
        o[d0] = __builtin_amdgcn_mfma_f32_32x32x16_bf16(pa0, (bf16x8){l0[0], l0[1], l0[2], l0[3], h0[0], h0[1], h0[2], h0[3]}, o[d0], 0, 0, 0);   \
        o[d0] = __builtin_amdgcn_mfma_f32_32x32x16_bf16(pa1, (bf16x8){l1[0], l1[1], l1[2], l1[3], h1[0], h1[1], h1[2], h1[3]}, o[d0], 0, 0, 0);   \
        o[d0] = __builtin_amdgcn_mfma_f32_32x32x16_bf16(pa2, (bf16x8){l2[0], l2[1], l2[2], l2[3], h2[0], h2[1], h2[2], h2[3]}, o[d0], 0, 0, 0);   \
        o[d0] = __builtin_amdgcn_mfma_f32_32x32x16_bf16(pa3, (bf16x8){l3[0], l3[1], l3[2], l3[3], h3[0], h3[1], h3[2], h3[3]}, o[d0], 0, 0, 0); } while (0)
    PV_D0(0); PV_D0(1); PV_D0(2); PV_D0(3);
#undef PV_D0
#undef TRRD
}

struct BlockRef { const bf16* Q; const bf16* K; const bf16* V; bf16* O; int P0; };
struct Seam { bf16x8 qr[8]; bf16x8 st_v0, st_v1, st_k0, st_k1; };
#define KVROW(p, k0, rr) ((const char*)(p) + (size_t)((k0) + (rr)) * (QPITCH * 2))
#define VMW() asm volatile("s_waitcnt vmcnt(0)" ::: "memory")
#define VMWN(n) asm volatile("s_waitcnt vmcnt(%0)" :: "i"(n) : "memory")
#define SLOAD_H(Kp, Vp, k0) do { S.st_v0 = *(const bf16x8*)(KVROW(Vp, k0, 0) + voffKV); S.st_v1 = *(const bf16x8*)(KVROW(Vp, k0, 32) + voffKV);              \
                         S.st_k0 = *(const bf16x8*)(KVROW(Kp, k0, 0) + voffKV); S.st_k1 = *(const bf16x8*)(KVROW(Kp, k0, 32) + voffKV); } while (0)
#define SWRITE_HK(bf) do { *(bf16x8*)(K_lds + (bf) * SHM_K + kws) = S.st_k0; *(bf16x8*)(K_lds + (bf) * SHM_K + kws + 32 * 256) = S.st_k1; } while (0)
#define SWRITE_HV(bf) do { *(bf16x8*)(V_lds + (bf) * SHM_V + vst0) = S.st_v0; *(bf16x8*)(V_lds + (bf) * SHM_V + vst1) = S.st_v1; } while (0)
#define SWRITE_H(bf) do { SWRITE_HV(bf); SWRITE_HK(bf); } while (0)
__device__ __forceinline__ void prime(const BlockRef& cur, char* lds, Seam& S, const int tid) {
    const int wid = __builtin_amdgcn_readfirstlane(tid >> 6), lane = tid & 63, r32 = lane & 31, hi = lane >> 5;
    const int sr = tid >> 4, sc = (tid & 15) * 8, kws = KSWZ(sr, sc * 2); char* K_lds = lds + NBUF * SHM_V;
    const unsigned voffKV = (unsigned)((sr * QPITCH + sc) * 2), voffQ = (unsigned)((r32 * QPITCH + hi * 8) * 2);
    { const char* qb = (const char*)cur.Q + (size_t)(wid * QBLK) * (QPITCH * 2);
#pragma unroll
      for (int d0 = 0; d0 < 8; ++d0) S.qr[d0] = *(const bf16x8*)(qb + d0 * 32 + voffQ); }
    SLOAD_H(cur.K, cur.V, (cur.P0 + QB - 1) / KVBLK * KVBLK); VMW(); SWRITE_HK(0);
    __syncthreads();
}
__device__ __forceinline__ void head_issue(const BlockRef& cur, char* lds, Seam& S, const int tid) {
    const int sr = tid >> 4, sc = (tid & 15) * 8, vst0 = v_st(sr, sc), vst1 = vst0 + 8192; char* V_lds = lds;
    const unsigned voffKV = (unsigned)((sr * QPITCH + sc) * 2);
    SWRITE_HV(0); SBAR();
    SLOAD_H(cur.K, cur.V, cur.P0 + QB - 2 * KVBLK); SBAR();
}
__device__ __forceinline__ void block(const BlockRef& cur, const BlockRef& nxt, char* lds, Seam& S, const int tid, const int T0) {
    const int wid = __builtin_amdgcn_readfirstlane(tid >> 6), lane = tid & 63, r32 = lane & 31, hi = lane >> 5;
    const int NTF = (cur.P0 + QB - 1) / KVBLK + 1;
    const int NT = NTF - T0;
    const int qlo = cur.P0 + wid * QBLK;
    char* V_lds = lds; char* K_lds = lds + NBUF * SHM_V;
    float* ws = (float*)(lds + NBUF * SHM_V + NBUF * SHM_K) + wid * 64; float* li_l = ws, * al_l = ws + 32;
    const char* bias_b = lds + BIAS_OFF;
    float m_reg = -1e30f, l_reg = 0; f32x16 o[4] = {};
    const int sr = tid >> 4, sc = (tid & 15) * 8, vst0 = v_st(sr, sc), vst1 = vst0 + 8192  , kws = KSWZ(sr, sc * 2);
    const int vb0 = (int)(uintptr_t)V_lds + v_rd_base(lane);
    const unsigned voffKV = (unsigned)((sr * QPITCH + sc) * 2), voffQ = (unsigned)((r32 * QPITCH + hi * 8) * 2);
    const bf16* Kh = cur.K; const bf16* Vh = cur.V;
#define RESC(a) do { if (__any((a) < 1.f)) { if (hi == 0) al_l[r32] = (a); asm volatile("s_waitcnt lgkmcnt(0)" ::: "memory");              \
                     for (int d_ = 0; d_ < 4; ++d_) for (int r = 0; r < 16; ++r) o[d_][r] *= al_l[crow(r, hi)]; } } while (0)
#define KBASE(t) ((NTF - 1 - (t)) * KVBLK)
#define MASKT(P0_, P1_, t) do { const int kb_ = KBASE(t); const int ln_ = lane_now(); \
        if (kb_ + KVBLK - 1 > qlo) mask_tile(P0_, P1_, qlo + (ln_ & 31) - 4 * (ln_ >> 5) - kb_); } while (0)
    constexpr int NQL = 8;
#define SEAM_K0() do { VMWN(NQL); SWRITE_HK(0); SBAR(); } while (0)
    f32x16 pA0, pA1, pB0, pB1; float mnA, mnB, alA, alB; bf16x8 pa0, pa1, pa2, pa3;
    SBAR(); qkt(0, pA0, pA1, K_lds, r32, hi, S.qr, bias_b + KBASE(0) * 4);
    bool deadA, deadB = true;
    MASKT(pA0, pA1, 0); deadA = partialSM(pA0, pA1, m_reg, mnA, alA);
    if (NT > 1) { VMW(); SWRITE_H(1); }
    __syncthreads();
#define HALF_STEP(PX0, PX1, mnX, alX, dX, PY0, PY1, alY, dY, t) do {                                                           \
        const int vbi_ = bt == 0 ? 2 : bt - 1, sbi_ = bt == 2 ? 0 : bt + 1;                                                    \
        SBAR();                                                                                                               \
        qkt(bt, PX0, PX1, K_lds, r32, hi, S.qr, bias_b + KBASE(t) * 4);                                                       \
        finishSM(PY0, PY1, alY, l_reg, pa0, pa1, pa2, pa3, dY);                                                              \
        SBAR();                                                                                                               \
        if ((t) + 1 < NT) { SLOAD_H(Kh, Vh, KBASE((t) + 1)); SBAR(); }                                                        \
        if (!(dY)) pv_tile(vbi_, o, vb0, pa0, pa1, pa2, pa3);                                                                 \
        MASKT(PX0, PX1, (t)); dX = partialSM(PX0, PX1, m_reg, mnX, alX);                                                      \
        if ((t) + 1 < NT) { VMW(); SWRITE_H(sbi_); }                                                                          \
        RESC(alX); __syncthreads(); bt = sbi_; } while (0)
    int bt = 1;
    for (int t = 1; t + 1 < NT; t += 2) {
        HALF_STEP(pB0, pB1, mnB, alB, deadB, pA0, pA1, alA, deadA, t);
        HALF_STEP(pA0, pA1, mnA, alA, deadA, pB0, pB1, alB, deadB, t + 1);
    }
    const bool even = (NT & 1) == 0;
    const int vba = bt == 0 ? 2 : bt - 1;
    if (even) { SBAR(); qkt(bt, pB0, pB1, K_lds, r32, hi, S.qr, bias_b + KBASE(NT - 1) * 4); SBAR(); }
    SLOAD_H(nxt.K, nxt.V, (nxt.P0 + QB - 1) / KVBLK * KVBLK); SBAR();
    { int tq = tid; asm volatile("" : "+v"(tq));
      const unsigned voffQ = (unsigned)((((tq & 31) * QPITCH) + ((tq >> 5) & 1) * 8) * 2);
      const char* qb = (const char*)nxt.Q + (size_t)(wid * QBLK) * (QPITCH * 2);
#pragma unroll
      for (int d0 = 0; d0 < 8; ++d0) S.qr[d0] = *(const bf16x8*)(qb + d0 * 32 + voffQ); }
    SBAR();
    if (!deadA) { finishSM(pA0, pA1, alA, l_reg, pa0, pa1, pa2, pa3); SBAR();
        pv_tile(vba, o, vb0, pa0, pa1, pa2, pa3); }
    if (even) { MASKT(pB0, pB1, NT - 1); deadB = partialSM(pB0, pB1, m_reg, mnB, alB); __syncthreads(); RESC(alB);
        if (!deadB) { finishSM(pB0, pB1, alB, l_reg, pa0, pa1, pa2, pa3); SBAR(); pv_tile(bt, o, vb0, pa0, pa1, pa2, pa3); } }
    SBAR(); SEAM_K0();
    if (hi == 0) li_l[r32] = l_reg; asm volatile("s_waitcnt lgkmcnt(0)" ::: "memory");
    int te = tid; asm volatile("" : "+v"(te));
    const int r32e = te & 31, hie = (te >> 5) & 1;
    float rli[16];
#pragma unroll
    for (int r = 0; r < 16; ++r) rli[r] = __builtin_amdgcn_rcpf(li_l[crow(r, hie)]);
    char* Ow = (char*)(cur.O + (size_t)(wid * QBLK) * OPITCH);
    const unsigned voff = (unsigned)((4 * hie * OPITCH + r32e) * 2);
#pragma unroll
    for (int r = 0; r < 16; ++r) { char* rb = Ow + (size_t)((r & 3) + 8 * (r >> 2)) * OPITCH * 2;
#pragma unroll
        for (int d0 = 0; d0 < 4; ++d0) { const float v = o[d0][r] * rli[r];
            const float vn = __shfl_xor(v, 1);
            if ((r32e & 1) == 0) *(unsigned*)(rb + d0 * 64 + voff) = cvtpk(v, vn); } }
    __syncthreads();
#undef RESC
#undef KBASE
#undef MASKT
#undef SEAM_K0
#undef HALF_STEP
}
#undef KVROW
#undef VMW
#undef VMWN
#undef SLOAD_H
#undef SWRITE_HK
#undef SWRITE_HV
#undef SWRITE_H
}
constexpr int NWAVES = 8, NTHREADS = 512, GRID = 256;
constexpr int BATCH = 4, SEQ = 8192, DM = 2048, DEPTH = 4, MROWS = BATCH * SEQ;
constexpr int MH = 4, DQK = 256, DV = 512, MLSTM_INW = 6152, NPROJ = 6144;
constexpr int FH = 16, FOX_INW = 6160;
constexpr int DFF = 5632, MODW = 6 * DM;
constexpr int LC = 256, NCH = SEQ / LC, NBH = BATCH * MH, NCHH = NBH * NCH;
constexpr float EPS = 1e-6f, SOFTCAP = 15.0f, SCALE_M = 0.0625f  , SCALE_A = 0.08838834764831845f  ;

constexpr size_t MiB = 1u << 20;
constexpr size_t WS_CTL = 0, CTL_ZERO_BYTES = 1 * MiB;
constexpr size_t WS_MOD = 1 * MiB;
constexpr size_t WS_WG = 3 * MiB;
constexpr size_t WS_WGF = WS_WG + 2 * 8 * 2048 * 4;
constexpr size_t WS_SCAN = 4 * MiB;
constexpr size_t WS_SA = WS_SCAN, WS_SM = WS_SA + 512 * 1024, WS_SF = WS_SM + 512 * 1024, WS_NB = WS_SF + 512 * 1024, WS_NST = WS_NB + 2 * MiB;
constexpr size_t WS_DNP = 10 * MiB;
constexpr size_t WS_GPRE = 8 * MiB;
constexpr size_t WS_WINM = 16 * MiB, WS_WINF = 64 * MiB, WS_WOUTM = 112 * MiB, WS_WOUTF = 128 * MiB, WS_WGU = 144 * MiB, WS_WDN = 320 * MiB;
constexpr size_t WS_H = 408 * MiB;
constexpr size_t WS_PROJ = 536 * MiB;
constexpr size_t WS_Y = 920 * MiB;
constexpr size_t WS_KWT = 1048 * MiB;
constexpr size_t WS_P = 1112 * MiB;
constexpr size_t WS_X = 1176 * MiB;
constexpr size_t WS_X2 = 1304 * MiB;
constexpr size_t WS_END = 1432 * MiB;
constexpr size_t OUT_CT2 = 128 * MiB;
constexpr int CW_KN = 256;
constexpr int CW_Q = 1024;
constexpr int CW_BAR = 4096;

constexpr int LDS_BYTES = 147456;
constexpr int MISC_OFF = LDS_BYTES - 1024;
constexpr int TR_SCR = 64 * 65 * 4;
static_assert(NWAVES * TR_SCR <= MISC_OFF && fa::LDS_BYTES <= MISC_OFF && pg8::STAGE_BYTES <= MISC_OFF, "LDS map");

#define GAS __attribute__((address_space(1)))
#define LAS __attribute__((address_space(3)))
typedef unsigned short bf16;
typedef unsigned v4u __attribute__((ext_vector_type(4)));
typedef unsigned v2u __attribute__((ext_vector_type(2)));
typedef float f32x4 __attribute__((ext_vector_type(4)));
typedef GAS unsigned gu32;
#define RLX_AGENT __ATOMIC_RELAXED, __HIP_MEMORY_SCOPE_AGENT
#define LDS_WAIT() asm volatile("s_waitcnt lgkmcnt(0)" ::: "memory")
#define VM_WAIT() asm volatile("s_waitcnt vmcnt(0)" ::: "memory")
__device__ __forceinline__ unsigned pk2(float lo, float hi) { unsigned r; asm volatile("v_cvt_pk_bf16_f32 %0, %1, %2" : "=v"(r) : "v"(lo), "v"(hi)); return r; }
__device__ __forceinline__ float bf_lo(unsigned w) { return __uint_as_float(w << 16); }
__device__ __forceinline__ float bf_hi(unsigned w) { return __uint_as_float(w & 0xffff0000u); }
__device__ __forceinline__ float h_lo(unsigned w) { return (float)__builtin_bit_cast(_Float16, (unsigned short)(w & 0xffffu)); }
__device__ __forceinline__ float h_hi(unsigned w) { return (float)__builtin_bit_cast(_Float16, (unsigned short)(w >> 16)); }
__device__ __forceinline__ unsigned pkh2(float lo, float hi) { const unsigned short a = __builtin_bit_cast(unsigned short, (_Float16)lo), b = __builtin_bit_cast(unsigned short, (_Float16)hi); return (unsigned)a | ((unsigned)b << 16); }
__device__ __forceinline__ f32x4 unpk_h4(v2u w) { const unsigned wx = w.x, wy = w.y; return (f32x4){h_lo(wx), h_hi(wx), h_lo(wy), h_hi(wy)}; }
__device__ __forceinline__ float wave_sum(float v) {
#pragma unroll
    for (int o = 1; o < 64; o <<= 1) v += __shfl_xor(v, o);
    return v;
}
__device__ __forceinline__ float sigmoidf_(float x) { return 1.0f / (1.0f + __expf(-x)); }
__device__ __forceinline__ float log1p01_(float e) { return e < 0.0078125f ? e * (1.0f + e * (-0.5f + e * (1.0f / 3.0f))) : __logf(1.0f + e); }
__device__ __forceinline__ float logsigmoidf_(float x) { return fminf(x, 0.f) - log1p01_(__expf(-fabsf(x))); }
__device__ __forceinline__ float tanhf_(float x) { const float e = __expf(-2.0f * fabsf(x)); const float t = (1.0f - e) / (1.0f + e); return x < 0.f ? -t : t; }

#define XB_TMO      128
#define XB_XCNT(j)  (256  + 64 * (j))
#define XB_XSUB(j)  (1280 + 64 * (j))
#define XB_XGEN(j)  (2304 + 64 * (j))
#define XB_TOP      3328
#define XB_TOPGEN   3392
#define XCD_BAR_WORDS 3456
#define XB_SPIN_CAP (1u << 18)
__device__ __forceinline__ unsigned xb_ld(unsigned* p)              { return __hip_atomic_load(p, __ATOMIC_RELAXED, __HIP_MEMORY_SCOPE_AGENT); }
__device__ __forceinline__ unsigned xb_add(unsigned* p, unsigned v) { return __hip_atomic_fetch_add(p, v, __ATOMIC_RELAXED, __HIP_MEMORY_SCOPE_AGENT); }
__device__ __forceinline__ unsigned xb_xcc_id() { return (unsigned)__builtin_amdgcn_s_getreg((3 << 11) | 20) & 0xFu; }
#define XB_SPIN(cond, bar) do { unsigned _sp = 0; while (cond) { __builtin_amdgcn_s_sleep(1); \
    if ((++_sp & 255u) == 0u) { if (xb_ld(&(bar)[XB_TMO])) break; if (_sp > XB_SPIN_CAP) { atomicAdd(&(bar)[XB_TMO], 1u); break; } } } } while (0)
struct XcdBarrier { unsigned* bar; unsigned x; volatile LAS unsigned* st; };
__device__ __forceinline__ XcdBarrier xcd_barrier_post(unsigned* bar, volatile LAS unsigned* st) {
    XcdBarrier b; b.bar = bar; b.x = xb_xcc_id(); b.st = st;
    if (threadIdx.x == 0) (void)xb_add(&bar[XB_XCNT(b.x)], 1u);
    return b;
}
__device__ __forceinline__ void xcd_barrier_complete(unsigned* bar, unsigned x, unsigned& nloc, unsigned& nx) {
    const unsigned G = gridDim.x * gridDim.y * gridDim.z;
    unsigned sum, cnt, mine, sp = 0u;
    for (;;) {
        sum = 0u; cnt = 0u; mine = 0u;
#pragma unroll
        for (unsigned j = 0; j < 16; ++j) { const unsigned c = xb_ld(&bar[XB_XCNT(j)]); sum += c; cnt += (c > 0u) ? 1u : 0u; mine = (j == x) ? c : mine; }
        if (sum == G) break;
        __builtin_amdgcn_s_sleep(1);
        if ((++sp & 255u) == 0u) { if (xb_ld(&bar[XB_TMO])) break; if (sp > XB_SPIN_CAP) { atomicAdd(&bar[XB_TMO], 1u); break; } }
    }
    nloc = mine > 0u ? mine : 1u; nx = cnt > 0u ? cnt : 1u;
}
__device__ __forceinline__ void xcd_barrier(const XcdBarrier& b) {
    asm volatile("s_waitcnt vmcnt(0)" ::: "memory");
    __syncthreads();
    if (threadIdx.x == 0) {
        unsigned* bar = b.bar;
        __builtin_amdgcn_s_waitcnt(0);
        unsigned nloc = b.st[0], nx = b.st[1];
        if (nloc == 0u) { xcd_barrier_complete(bar, b.x, nloc, nx); b.st[0] = nloc; b.st[1] = nx; }
        const unsigned old = xb_add(&bar[XB_XSUB(b.x)], 1u);
        const unsigned gen = old / nloc;
        if (old + 1u == (gen + 1u) * nloc) {
            __builtin_amdgcn_fence(__ATOMIC_RELEASE, "agent");
            asm volatile("s_waitcnt vmcnt(0)" ::: "memory");
            const unsigned og = xb_add(&bar[XB_TOP], 1u);
            const unsigned tg = og / nx;
            if (og + 1u == (tg + 1u) * nx) xb_add(&bar[XB_TOPGEN], 1u);
            else XB_SPIN(xb_ld(&bar[XB_TOPGEN]) == tg, bar);
            __builtin_amdgcn_fence(__ATOMIC_ACQUIRE, "agent");
            xb_add(&bar[XB_XGEN(b.x)], 1u);
            asm volatile("s_waitcnt vmcnt(0)" ::: "memory");
        } else {
            XB_SPIN(xb_ld(&bar[XB_XGEN(b.x)]) == gen, bar);
            __builtin_amdgcn_fence(__ATOMIC_ACQUIRE, "agent");
            asm volatile("s_waitcnt vmcnt(0)" ::: "memory");
        }
    }
    __syncthreads();
}

struct Args { const float* in[16]; float* out; unsigned char* ws; int ph_lo, ph_hi, li, pad; };
typedef const __attribute__((address_space(4))) Args* KArgP;
__device__ __forceinline__ KArgP kargs() { KArgP p = (KArgP)__builtin_amdgcn_kernarg_segment_ptr(); asm volatile("" : "+s"(p)); return p; }
struct Frame {
    LAS unsigned char* lds;
    int tid, lane, wave, bid, wave0;
    KArgP ka;
};
__device__ __forceinline__ void refresh(Frame& F) { F.ka = kargs();
    int t; asm volatile("v_mbcnt_lo_u32_b32 %0, -1, 0\n\tv_mbcnt_hi_u32_b32 %0, -1, %0" : "=v"(t));
    t += F.wave0 * 64; F.tid = t; { int b_ = (int)blockIdx.x; asm volatile("" : "+s"(b_)); F.bid = b_; } F.lane = t & 63; F.wave = __builtin_amdgcn_readfirstlane(t >> 6); }

__device__ __forceinline__ void tr_out(LAS float* scr, bf16* dst  , size_t ldt, int lane) {
    const int nl = lane & 7, c = lane >> 3;
#pragma unroll
    for (int j = 0; j < 8; ++j) { const int n = nl + 8 * j; const LAS float* s = scr + (8 * c) * 65 + n;
        v4u o; o.x = pk2(s[0], s[65]); o.y = pk2(s[130], s[195]); o.z = pk2(s[260], s[325]); o.w = pk2(s[390], s[455]);
        *(GAS v4u*)(dst + (size_t)n * ldt + 8 * c) = o; }
    LDS_WAIT();
}
__device__ __forceinline__ void tr_load_f32(f32x4 (&v)[16], const float* src  , size_t lds_, int lane) {
    const int cq = lane & 15, rq = lane >> 4;
#pragma unroll
    for (int i = 0; i < 16; ++i) v[i] = *(const GAS f32x4*)(src + (size_t)(rq + 4 * i) * lds_ + 4 * cq);
}
__device__ __forceinline__ void tr_stage_f32(const f32x4 (&v)[16], bf16* dst, size_t ldt, LAS float* scr, int lane) {
    const int cq = lane & 15, rq = lane >> 4;
#pragma unroll
    for (int i = 0; i < 16; ++i) { LAS float* d = scr + (rq + 4 * i) * 65 + 4 * cq; d[0] = v[i].x; d[1] = v[i].y; d[2] = v[i].z; d[3] = v[i].w; }
    LDS_WAIT();
    tr_out(scr, dst, ldt, lane);
}

__device__ __forceinline__ void p0_prologue(Frame& F) {
    const int tid = F.tid, lane = F.lane, wave = F.wave;
    {
        const int u = F.bid;
        if (u < 256) {
            const int l = u >> 6, cg = u & 63;
            f32x4 acc[4];
#pragma unroll
            for (int b = 0; b < 4; ++b) acc[b] = (f32x4){0.f, 0.f, 0.f, 0.f};
            if (lane < 48) {
                const float* W = F.ka->in[2] + (size_t)l * DM * MODW + cg * 192 + 4 * lane;
                const int kb = wave * 256;
                for (int kk = 0; kk < 256; kk += 8) {
                    f32x4 w[8];
#pragma unroll
                    for (int j = 0; j < 8; ++j) w[j] = *(const GAS f32x4*)(W + (size_t)(kb + kk + j) * MODW);
#pragma unroll
                    for (int j = 0; j < 8; ++j) {
#pragma unroll
                        for (int b = 0; b < 4; ++b) { const float cv = F.ka->in[1][b * DM + kb + kk + j]; const float s = cv * sigmoidf_(cv); acc[b] += w[j] * s; } }
                }
            }
            LAS float* red = (LAS float*)F.lds;
            if (lane < 48) {
#pragma unroll
                for (int b = 0; b < 4; ++b) *(LAS f32x4*)(red + (wave * 4 + b) * 192 + 4 * lane) = acc[b]; }
            __syncthreads();
            for (int o = tid; o < 768; o += NTHREADS) { const int b = o / 192, col = o % 192; float s = 0.f;
#pragma unroll
                for (int w = 0; w < 8; ++w) s += red[(w * 4 + b) * 192 + col];
                const int j = cg * 192 + col;
                ((float*)(F.ka->ws + WS_MOD))[(size_t)(l * 4 + b) * MODW + j] = s + F.ka->in[3][(size_t)l * MODW + j]; }
            __syncthreads();
        }
    }
    {
        const int gt = F.bid * NTHREADS + tid;
        if (gt < 2 * 8 * 2048) { const int j = gt / (8 * 2048), r = gt % (8 * 2048), g = r / 2048, k = r % 2048;
            ((float*)(F.ka->ws + WS_WG))[gt] = F.ka->in[6][((size_t)j * DM + k) * MLSTM_INW + NPROJ + g]; }
        else if (gt < 2 * 8 * 2048 + 2 * 16 * 2048) { const int q = gt - 2 * 8 * 2048; const int j = q / (16 * 2048), r = q % (16 * 2048), g = r / 2048, k = r % 2048;
            ((float*)(F.ka->ws + WS_WGF))[q] = F.ka->in[10][((size_t)j * DM + k) * FOX_INW + NPROJ + g]; }
    }
    {
        LAS float* scr = (LAS float*)(F.lds + wave * TR_SCR);
        const int gw = F.bid * NWAVES + wave, NGW = GRID * NWAVES;
        constexpr int I_IN = 32 * 96, I_OUT = 32 * 32, I_GU = 32 * 176, I_DN = 88 * 32;
        constexpr int E0 = 2 * I_IN, E1 = E0 + 2 * I_IN, E2 = E1 + 2 * I_OUT, E3 = E2 + 2 * I_OUT, E4 = E3 + 4 * I_GU, E5 = E4 + 4 * I_DN;
#define P0_DECODE(it_, src_, lds_, dst_, ldt_) do { \
            if ((it_) < E0) { const int j = (it_) / I_IN, r = (it_) % I_IN, kb = r / 96, nb = r % 96; \
                src_ = F.ka->in[6] + ((size_t)j * DM + kb * 64) * MLSTM_INW + nb * 64; lds_ = MLSTM_INW; dst_ = (bf16*)(F.ka->ws + WS_WINM) + ((size_t)j * NPROJ + nb * 64) * DM + kb * 64; ldt_ = DM; } \
            else if ((it_) < E1) { const int q = (it_) - E0, j = q / I_IN, r = q % I_IN, kb = r / 96, nb = r % 96; \
                src_ = F.ka->in[10] + ((size_t)j * DM + kb * 64) * FOX_INW + nb * 64; lds_ = FOX_INW; dst_ = (bf16*)(F.ka->ws + WS_WINF) + ((size_t)j * NPROJ + nb * 64) * DM + kb * 64; ldt_ = DM; } \
            else if ((it_) < E2) { const int q = (it_) - E1, j = q / I_OUT, r = q % I_OUT, kb = r / 32, nb = r % 32; \
                src_ = F.ka->in[9] + ((size_t)j * DM + kb * 64) * DM + nb * 64; lds_ = DM; dst_ = (bf16*)(F.ka->ws + WS_WOUTM) + ((size_t)j * DM + nb * 64) * DM + kb * 64; ldt_ = DM; } \
            else if ((it_) < E3) { const int q = (it_) - E2, j = q / I_OUT, r = q % I_OUT, kb = r / 32, nb = r % 32; \
                src_ = F.ka->in[12] + ((size_t)j * DM + kb * 64) * DM + nb * 64; lds_ = DM; dst_ = (bf16*)(F.ka->ws + WS_WOUTF) + ((size_t)j * DM + nb * 64) * DM + kb * 64; ldt_ = DM; } \
            else if ((it_) < E4) { const int q = (it_) - E3, j = q / I_GU, r = q % I_GU, kb = r / 176, nb = r % 176; \
                const int n0 = nb * 64, jj = n0 < DFF ? n0 : n0 - DFF, drow = (jj >> 7) * 256 + (n0 < DFF ? 0 : 128) + (jj & 127); \
                src_ = F.ka->in[13] + ((size_t)j * DM + kb * 64) * (2 * DFF) + n0; lds_ = 2 * DFF; dst_ = (bf16*)(F.ka->ws + WS_WGU) + ((size_t)j * 2 * DFF + drow) * DM + kb * 64; ldt_ = DM; } \
            else { const int q = (it_) - E4, j = q / I_DN, r = q % I_DN, kb = r / 32, nb = r % 32; \
                src_ = F.ka->in[14] + ((size_t)j * DFF + kb * 64) * DM + nb * 64; lds_ = DM; dst_ = (bf16*)(F.ka->ws + WS_WDN) + ((size_t)j * DM + nb * 64) * DFF + kb * 64; ldt_ = DFF; } } while (0)
        for (int it = gw; it < E5; it += 2 * NGW) {
            const int it2 = it + NGW; const bool two = it2 < E5;
            const float *srcA, *srcB = nullptr; bf16 *dstA, *dstB = nullptr; size_t lsA, lsB = 0, ltA, ltB = 0;
            P0_DECODE(it, srcA, lsA, dstA, ltA);
            if (two) P0_DECODE(it2, srcB, lsB, dstB, ltB);
            f32x4 va[16], vb[16];
            tr_load_f32(va, srcA, lsA, lane);
            if (two) tr_load_f32(vb, srcB, lsB, lane);
            tr_stage_f32(va, dstA, ltA, scr, lane);
            if (two) tr_stage_f32(vb, dstB, ltB, scr, lane);
        }
#undef P0_DECODE
    }
}

template <bool XF> struct XRaw { typedef v2u type; };
template <> struct XRaw<true> { typedef f32x4 type; };
__device__ __forceinline__ f32x4 np_cvt(f32x4 w) { return w; }
__device__ __forceinline__ f32x4 np_cvt(v2u w) { return unpk_h4(w); }
template <int NG, bool XF>
__device__ __forceinline__ void norm_phase(Frame& F, const void* xsrc_, const float* nw, const float* mod_l, int sh_off, int sc_off, const float* Wg) {
    const float* xsrc = (const float*)xsrc_; const unsigned short* xh = (const unsigned short*)xsrc_;
    typedef typename XRaw<XF>::type raw_t;
    constexpr bool PREG = !XF;
#define NP_LDX(r_, j_) (XF ? *(const GAS raw_t*)(xsrc + (size_t)(r_) * DM + 256 * (j_) + 4 * lane) : *(const GAS raw_t*)(xh + (size_t)(r_) * DM + 256 * (j_) + 4 * lane))
    const int tid = F.tid, lane = F.lane, wave = F.wave;
    if constexpr (NG > 0) {
        for (int i = tid; i < NG * 512; i += NTHREADS) ((LAS f32x4*)F.lds)[i] = ((const GAS f32x4*)Wg)[i];
        __syncthreads();
    }
    bf16* H = (bf16*)(F.ka->ws + WS_H); float* gpre = (float*)(F.ka->ws + WS_GPRE);
    const int gw = F.bid * NWAVES + wave, rows_per = MROWS / (GRID * NWAVES);
    const int row0 = gw * rows_per, b = row0 / SEQ;
    const float* scp = mod_l + (size_t)b * MODW + sc_off + 4 * lane; const float* shp = mod_l + (size_t)b * MODW + sh_off + 4 * lane; const float* nwp = nw + 4 * lane;
    f32x4 y0[8], y1[8];
#pragma unroll
    for (int j = 0; j < 8; ++j) { y0[j] = np_cvt(NP_LDX(row0, j)); y1[j] = np_cvt(NP_LDX(row0 + 1, j)); }
    f32x4 pav[PREG ? 8 : 1], shv[PREG ? 8 : 1];
    if constexpr (PREG) {
#pragma unroll
        for (int j = 0; j < 8; ++j) { const f32x4 w = *(const GAS f32x4*)(nwp + 256 * j), sc = *(const GAS f32x4*)(scp + 256 * j); pav[j] = w * (sc + 1.0f); shv[j] = *(const GAS f32x4*)(shp + 256 * j); } }
    for (int rp = 0; rp < rows_per; rp += 2) {
        const int r0 = row0 + rp;
        if constexpr (!PREG) asm volatile("" : "+v"(scp), "+v"(shp), "+v"(nwp));
        const int rn = (rp + 2 < rows_per) ? r0 + 2 : r0;
        raw_t n0[8], n1[8];
#pragma unroll
        for (int j = 0; j < 8; ++j) { n0[j] = NP_LDX(rn, j); n1[j] = NP_LDX(rn + 1, j); }
        float s0 = 0.f, s1 = 0.f;
#pragma unroll
        for (int j = 0; j < 8; ++j) { s0 += (y0[j].x * y0[j].x + y0[j].y * y0[j].y) + (y0[j].z * y0[j].z + y0[j].w * y0[j].w); s1 += (y1[j].x * y1[j].x + y1[j].y * y1[j].y) + (y1[j].z * y1[j].z + y1[j].w * y1[j].w); }
        s0 = wave_sum(s0); s1 = wave_sum(s1);
        const float rs0 = rsqrtf(s0 * (1.0f / DM) + EPS), rs1 = rsqrtf(s1 * (1.0f / DM) + EPS);
#pragma unroll
        for (int j = 0; j < 8; ++j) { f32x4 pa, sh;
            if constexpr (PREG) { pa = pav[j]; sh = shv[j]; }
            else { const f32x4 w = *(const GAS f32x4*)(nwp + 256 * j), sc = *(const GAS f32x4*)(scp + 256 * j); sh = *(const GAS f32x4*)(shp + 256 * j); pa = w * (sc + 1.0f); }
            y0[j] = y0[j] * rs0 * pa + sh; y1[j] = y1[j] * rs1 * pa + sh;
            v2u o0, o1; o0.x = pk2(y0[j].x, y0[j].y); o0.y = pk2(y0[j].z, y0[j].w); o1.x = pk2(y1[j].x, y1[j].y); o1.y = pk2(y1[j].z, y1[j].w);
            *(GAS v2u*)(H + (size_t)r0 * DM + 256 * j + 4 * lane) = o0; *(GAS v2u*)(H + (size_t)(r0 + 1) * DM + 256 * j + 4 * lane) = o1; }
        if constexpr (NG > 0) {
#pragma unroll 1
            for (int g0 = 0; g0 < NG; g0 += 2) {
                const LAS float* wl = (const LAS float*)F.lds + g0 * DM + 4 * lane;
                float t00 = 0.f, t01 = 0.f, t10 = 0.f, t11 = 0.f;
#pragma unroll
                for (int j = 0; j < 8; ++j) { const f32x4 wa = *(const LAS f32x4*)(wl + 256 * j), wb = *(const LAS f32x4*)(wl + DM + 256 * j);
                    t00 += (y0[j].x * wa.x + y0[j].y * wa.y) + (y0[j].z * wa.z + y0[j].w * wa.w); t01 += (y0[j].x * wb.x + y0[j].y * wb.y) + (y0[j].z * wb.z + y0[j].w * wb.w);
                    t10 += (y1[j].x * wa.x + y1[j].y * wa.y) + (y1[j].z * wa.z + y1[j].w * wa.w); t11 += (y1[j].x * wb.x + y1[j].y * wb.y) + (y1[j].z * wb.z + y1[j].w * wb.w); }
                { const bool u5 = (lane & 32) != 0, u4 = (lane & 16) != 0;
                  const float k0 = u5 ? t10 : t00, k1 = u5 ? t11 : t01, s0 = u5 ? t00 : t10, s1 = u5 ? t01 : t11;
                  const float a0 = k0 + __shfl_xor(s0, 32), a1 = k1 + __shfl_xor(s1, 32);
                  float c = (u4 ? a1 : a0) + __shfl_xor(u4 ? a0 : a1, 16);
                  c += __shfl_xor(c, 8); c += __shfl_xor(c, 4); c += __shfl_xor(c, 2); c += __shfl_xor(c, 1);
                  if ((lane & 15) == 0) gpre[(size_t)(g0 + (u4 ? 1 : 0)) * MROWS + r0 + (u5 ? 1 : 0)] = c; }
            }
        }
#pragma unroll
        for (int j = 0; j < 8; ++j) { y0[j] = np_cvt(n0[j]); y1[j] = np_cvt(n1[j]); }
    }
    if constexpr (NG > 0) __syncthreads();
#undef NP_LDX
}

__device__ __forceinline__ float block_excl_sum(Frame& F, float tot, LAS float* scr) {
    float inc = tot;
#pragma unroll
    for (int o = 1; o < 64; o <<= 1) { const float t = __shfl_up(inc, o); if (F.lane >= o) inc += t; }
    if (F.lane == 63) scr[F.wave] = inc;
    __syncthreads();
    float base = 0.f;
    for (int w = 0; w < F.wave; ++w) base += scr[w];
    __syncthreads();
    return base + inc - tot;
}
__device__ __forceinline__ float block_excl_max(Frame& F, float tot, LAS float* scr) {
    float inc = tot;
#pragma unroll
    for (int o = 1; o < 64; o <<= 1) { const float t = __shfl_up(inc, o); if (F.lane >= o) inc = fmaxf(inc, t); }
    if (F.lane == 63) scr[F.wave] = inc;
    __syncthreads();
    float base = -__builtin_inff();
    for (int w = 0; w < F.wave; ++w) base = fmaxf(base, scr[w]);
    __syncthreads();
    const float prev = __shfl_up(inc, 1);
    return fmaxf(base, F.lane > 0 ? prev : -__builtin_inff());
}
__device__ __forceinline__ void mlstm_gate_scan(Frame& F, int bh, const float* bgates  ) {
    const int b = bh >> 2, h = bh & 3, t0 = F.tid * 16;
    const float* gpi = (const float*)(F.ka->ws + WS_GPRE) + (size_t)h * MROWS + (size_t)b * SEQ + t0;
    const float* gpf = gpi + (size_t)4 * MROWS;
    LAS float* scr = (LAS float*)F.lds;
    const float bi = bgates[h], bf = bgates[4 + h];
    float gI[16], gF[16];
#pragma unroll
    for (int q = 0; q < 4; ++q) { const f32x4 a = *(const GAS f32x4*)(gpi + 4 * q), c = *(const GAS f32x4*)(gpf + 4 * q);
        gI[4 * q] = a.x; gI[4 * q + 1] = a.y; gI[4 * q + 2] = a.z; gI[4 * q + 3] = a.w; gF[4 * q] = c.x; gF[4 * q + 1] = c.y; gF[4 * q + 2] = c.z; gF[4 * q + 3] = c.w; }
    float li[16], fc[16];
    float run = 0.f;
#pragma unroll
    for (int i = 0; i < 16; ++i) { const float gi = gI[i] + bi, gf = gF[i] + bf;
        li[i] = SOFTCAP * tanhf_(gi * (1.0f / SOFTCAP)); const float lf = logsigmoidf_(SOFTCAP * tanhf_(gf * (1.0f / SOFTCAP))); run += lf; fc[i] = run; }
    const float basef = block_excl_sum(F, run, scr);
    float am = -__builtin_inff(); float av[16];
#pragma unroll
    for (int i = 0; i < 16; ++i) { fc[i] += basef; av[i] = li[i] - fc[i]; am = fmaxf(am, av[i]); }
    float m = fmaxf(block_excl_max(F, am, scr), 0.f);
    float* SA = (float*)(F.ka->ws + WS_SA) + (size_t)bh * SEQ + t0; float* SM = (float*)(F.ka->ws + WS_SM) + (size_t)bh * SEQ + t0; float* SF = (float*)(F.ka->ws + WS_SF) + (size_t)bh * SEQ + t0;
#pragma unroll
    for (int i = 0; i < 16; ++i) { m = fmaxf(m, av[i]); SA[i] = av[i]; SM[i] = m; SF[i] = fc[i]; }
}
__device__ __forceinline__ void fox_gate_scan(Frame& F, int bh, const float* bfv  ) {
    const int b = bh >> 4, h = bh & 15, t0 = F.tid * 16;
    const float* gp = (const float*)(F.ka->ws + WS_GPRE) + (size_t)h * MROWS + (size_t)b * SEQ + t0;
    LAS float* scr = (LAS float*)F.lds;
    const float bb = bfv[h];
    float gv[16];
#pragma unroll
    for (int q = 0; q < 4; ++q) { const f32x4 a = *(const GAS f32x4*)(gp + 4 * q); gv[4 * q] = a.x; gv[4 * q + 1] = a.y; gv[4 * q + 2] = a.z; gv[4 * q + 3] = a.w; }
    float fc[16]; float run = 0.f;
#pragma unroll
    for (int i = 0; i < 16; ++i) { run += logsigmoidf_(gv[i] + bb); fc[i] = run; }
    const float basef = block_excl_sum(F, run, scr);
    float* NB = (float*)(F.ka->ws + WS_NB) + (size_t)bh * SEQ + t0;
#pragma unroll
    for (int i = 0; i < 16; ++i) NB[i] = -(fc[i] + basef) * (1.0f / SCALE_A);
}

struct MainSched {
    pg8::TileOrder T; const char* A; const char* B; char* O; size_t tA, tB, tOm, tOn;
    __device__ __forceinline__ bool next(int i, pg8::Unit& u) const { int pm, pn; if (!T.tile(i, pm, pn)) return false;
        u.pm = pm; u.pn = pn; u.A = A + (size_t)pm * tA; u.B = B + (size_t)pn * tB; u.A1 = nullptr; u.B1 = nullptr; u.O = O + (size_t)pm * tOm + (size_t)pn * tOn; return true; }
};
struct EpiStore {
    static constexpr bool PERM = true; int ldo; unsigned* kn;
    __device__ __forceinline__ void operator()(const pg8::f32x4 (&acc)[2][2][4][2], const pg8::Unit& u, int wr, int wc, int fr, int fq, PG8_LAS unsigned char* scr) const {
        if (kn != nullptr && u.pn >= 8 && u.pn < 16) {
            float km0 = 0.f, km1 = 0.f;
#pragma unroll
            for (int ai = 0; ai < 2; ++ai)
#pragma unroll
                for (int m = 0; m < 4; ++m) {
                    float s0 = 0.f, s1 = 0.f;
#pragma unroll
                    for (int n = 0; n < 2; ++n)
#pragma unroll
                        for (int e = 0; e < 4; ++e) { s0 = fmaf(acc[ai][0][m][n][e], acc[ai][0][m][n][e], s0); s1 = fmaf(acc[ai][1][m][n][e], acc[ai][1][m][n][e], s1); }
                    s0 += __shfl_xor(s0, 16); s1 += __shfl_xor(s1, 16); s0 += __shfl_xor(s0, 32); s1 += __shfl_xor(s1, 32);
                    km0 = fmaxf(km0, s0); km1 = fmaxf(km1, s1); }
#pragma unroll
            for (int o = 1; o < 16; o <<= 1) { km0 = fmaxf(km0, __shfl_xor(km0, o)); km1 = fmaxf(km1, __shfl_xor(km1, o)); }
            if (fq == 0 && fr == 0) { unsigned* kp = kn + (((u.pm >> 5) * 16 + 2 * (u.pn - 8)) * 4 + wc);
                atomicMax(kp, __float_as_uint(km0)); atomicMax(kp + 4, __float_as_uint(km1)); }
        }
        const int lane = fq * 16 + fr, rr = lane >> 2, ch = lane & 3;
        bf16* base = (bf16*)u.O + (size_t)(wr * 64 + rr) * ldo + wc * 32 + 8 * ch;
        PG8_LAS unsigned char* wp = scr + fr * 64 + ((fq ^ ((fr >> 1) & 3)) * 16);
        PG8_LAS unsigned char* rp = scr + rr * 64 + ((ch ^ ((rr >> 1) & 3)) * 16);
#pragma unroll
        for (int ai = 0; ai < 2; ++ai)
#pragma unroll
            for (int m = 0; m < 4; ++m) { bf16* rowp = base + (size_t)(ai * 128 + m * 16) * ldo;
#pragma unroll
                for (int bj = 0; bj < 2; ++bj) { const pg8::f32x4 v0 = acc[ai][bj][m][0], v1 = acc[ai][bj][m][1];
                    v4u w; w.x = pk2(v0[0], v0[1]); w.y = pk2(v0[2], v0[3]); w.z = pk2(v1[0], v1[1]); w.w = pk2(v1[2], v1[3]);
                    *(PG8_LAS v4u*)(wp + bj * 8192) = w;
                    const v4u t = *(const PG8_LAS v4u*)(rp + bj * 8192);
                    *(GAS v4u*)(rowp + bj * 128) = t; } }
    }
};
struct EpiSwiglu {
    static constexpr bool PERM = true;
    __device__ __forceinline__ void operator()(const pg8::f32x4 (&acc)[2][2][4][2], const pg8::Unit& u, int wr, int wc, int fr, int fq, PG8_LAS unsigned char* scr) const {
        const int lane = fq * 16 + fr, rr = lane >> 2, ch = lane & 3;
        bf16* base = (bf16*)u.O + (size_t)(wr * 64 + rr) * DFF + wc * 32 + 8 * ch;
        PG8_LAS unsigned char* wp = scr + fr * 64 + ((fq ^ ((fr >> 1) & 3)) * 16);
        PG8_LAS unsigned char* rp = scr + rr * 64 + ((ch ^ ((rr >> 1) & 3)) * 16);
#pragma unroll
        for (int ai = 0; ai < 2; ++ai)
#pragma unroll
            for (int m = 0; m < 4; ++m) { float r[8];
#pragma unroll
                for (int n = 0; n < 2; ++n)
#pragma unroll
                    for (int e = 0; e < 4; ++e) { const float g = acc[ai][0][m][n][e], up = acc[ai][1][m][n][e]; r[4 * n + e] = g * up * __builtin_amdgcn_rcpf(1.0f + __expf(-g)); }
                v4u w; w.x = pk2(r[0], r[1]); w.y = pk2(r[2], r[3]); w.z = pk2(r[4], r[5]); w.w = pk2(r[6], r[7]);
                *(PG8_LAS v4u*)(wp + (m & 1) * 8192) = w;
                const v4u t = *(const PG8_LAS v4u*)(rp + (m & 1) * 8192);
                *(GAS v4u*)(base + (size_t)(ai * 128 + m * 16) * DFF) = t; }
    }
};
template <bool XF, int AH = 2>
struct EpiResid {
    static constexpr bool PERM = false; const float* gate_l  ; const void* xin  ;
    static constexpr int AHEAD = XF ? 2 : AH, NB = (AHEAD == 8) ? 8 : 3;
    __device__ __forceinline__ void operator()(const pg8::f32x4 (&acc)[2][2][4][2], const pg8::Unit& u, int wr, int wc, int fr, int fq, PG8_LAS unsigned char* scr) const {
        const int b = u.pm >> 5;
        const int lane = fq * 16 + fr, rr = lane >> 2, c2 = lane & 3;
        const float* gp = gate_l + (size_t)b * MODW + u.pn * 256 + wc * 32 + 8 * c2;
        pg8::f32x4 gv[2][2];
#pragma unroll
        for (int bj = 0; bj < 2; ++bj) { gv[bj][0] = *(const GAS pg8::f32x4*)(gp + bj * 128); gv[bj][1] = *(const GAS pg8::f32x4*)(gp + bj * 128 + 4); }
        unsigned short* obase = (unsigned short*)u.O + (size_t)(wr * 64 + rr) * DM + wc * 32 + 8 * c2;
        const size_t eoff = (size_t)(u.pm * 256 + wr * 64 + rr) * DM + u.pn * 256 + wc * 32 + 8 * c2;
        PG8_LAS unsigned char* wp0 = scr + (fr >> 3) * 8192 + (fr & 7) * 128;
        const int wx0 = ((fq) ^ (fr & 7)) * 16, wx1 = ((4 + fq) ^ (fr & 7)) * 16;
        PG8_LAS unsigned char* rp0 = scr + (rr >> 3) * 8192 + (rr & 7) * 128;
        const int rx0 = ((2 * c2) ^ (rr & 7)) * 16, rx1 = ((2 * c2 + 1) ^ (rr & 7)) * 16;
        v4u xh[XF ? 1 : NB][2]; pg8::f32x4 xf[XF ? NB : 1][4];
#define ER_LOAD(g_) do { const size_t q_ = eoff + (size_t)(((g_) >> 2) * 128 + ((g_) & 3) * 16) * DM; \
            if constexpr (XF) { const float* f_ = (const float*)xin + q_; xf[(g_) % NB][0] = *(const GAS pg8::f32x4*)f_; xf[(g_) % NB][1] = *(const GAS pg8::f32x4*)(f_ + 4); \
                xf[(g_) % NB][2] = *(const GAS pg8::f32x4*)(f_ + 128); xf[(g_) % NB][3] = *(const GAS pg8::f32x4*)(f_ + 132); } \
            else { const unsigned short* h_ = (const unsigned short*)xin + q_; xh[(g_) % NB][0] = *(const GAS v4u*)h_; xh[(g_) % NB][1] = *(const GAS v4u*)(h_ + 128); } } while (0)
#pragma unroll
        for (int g = 0; g < AHEAD; ++g) ER_LOAD(g);
#pragma unroll
        for (int g = 0; g < 8; ++g) { const int ai = g >> 2, m = g & 3; unsigned short* p = obase + (size_t)(ai * 128 + m * 16) * DM;
            if (g + AHEAD < 8) ER_LOAD(g + AHEAD);
#pragma unroll
            for (int bj = 0; bj < 2; ++bj) {
                *(PG8_LAS pg8::f32x4*)(wp0 + wx0) = acc[ai][bj][m][0]; *(PG8_LAS pg8::f32x4*)(wp0 + wx1) = acc[ai][bj][m][1];
                const pg8::f32x4 va = *(const PG8_LAS pg8::f32x4*)(rp0 + rx0), vb = *(const PG8_LAS pg8::f32x4*)(rp0 + rx1);
                pg8::f32x4 xa, xb;
                if constexpr (XF) { xa = xf[g % NB][2 * bj]; xb = xf[g % NB][2 * bj + 1]; }
                else { const v4u w = xh[g % NB][bj]; xa = (pg8::f32x4){h_lo(w.x), h_hi(w.x), h_lo(w.y), h_hi(w.y)}; xb = (pg8::f32x4){h_lo(w.z), h_hi(w.z), h_lo(w.w), h_hi(w.w)}; }
                const pg8::f32x4 ra = xa + gv[bj][0] * va, rb = xb + gv[bj][1] * vb;
                v4u o; o.x = pkh2(ra[0], ra[1]); o.y = pkh2(ra[2], ra[3]); o.z = pkh2(rb[0], rb[1]); o.w = pkh2(rb[2], rb[3]);
                *(GAS v4u*)(p + bj * 128) = o;
            } }
#undef ER_LOAD
    }
};
struct SchedS {
    int G, c; const char* proj; char* P;
    __device__ __forceinline__ bool next(int i, pg8::Unit& u) const { const int L0 = i * G + c; if (L0 >= NCHH) return false;
        const int L = (L0 & 7) * (NCHH / 8) + (L0 >> 3);
        const int bh = L >> 5, cc = L & 31, b = bh >> 2, h = bh & 3; const size_t row0 = (size_t)b * SEQ + cc * LC;
        u.pm = L; u.pn = 0; u.A = proj + (row0 * NPROJ + h * DQK) * 2; u.B = proj + (row0 * NPROJ + 1024 + h * DQK) * 2; u.A1 = nullptr; u.B1 = nullptr; u.O = P + (size_t)L * LC * LC * 2; return true; }
};
struct EpiS {
    static constexpr bool PERM = true; const float* SA; const float* SM;
    __device__ __forceinline__ void operator()(const pg8::f32x4 (&acc)[2][2][4][2], const pg8::Unit& u, int wr, int wc, int fr, int fq, PG8_LAS unsigned char* scr) const {
        const float* sa = SA + (size_t)u.pm * LC; const float* sm = SM + (size_t)u.pm * LC;
        bf16* base = (bf16*)u.O + (size_t)(wr * 64 + fr) * LC + wc * 32 + 8 * fq;
        pg8::f32x4 av[2][2];
#pragma unroll
        for (int bj = 0; bj < 2; ++bj)
#pragma unroll
            for (int n = 0; n < 2; ++n) av[bj][n] = *(const GAS pg8::f32x4*)(sa + bj * 128 + wc * 32 + 8 * fq + 4 * n);
#pragma unroll
        for (int ai = 0; ai < 2; ++ai)
#pragma unroll
            for (int m = 0; m < 4; ++m) { const int t = ai * 128 + wr * 64 + m * 16 + fr; const float mt = sm[t];
#pragma unroll
                for (int bj = 0; bj < 2; ++bj) { float r[8];
#pragma unroll
                    for (int n = 0; n < 2; ++n)
#pragma unroll
                        for (int e = 0; e < 4; ++e) { const int s = bj * 128 + wc * 32 + 8 * fq + 4 * n + e;
                            r[4 * n + e] = (s <= t) ? SCALE_M * acc[ai][bj][m][n][e] * __expf(av[bj][n][e] - mt) : 0.f; }
                    v4u w; w.x = pk2(r[0], r[1]); w.y = pk2(r[2], r[3]); w.z = pk2(r[4], r[5]); w.w = pk2(r[6], r[7]);
                    *(GAS v4u*)(base + (size_t)(ai * 128 + m * 16) * LC + bj * 128) = w; } }
    }
};
struct SchedDC {
    int G, c; const char* VT; const char* KWT; char* CT;
    __device__ __forceinline__ bool next(int i, pg8::Unit& u) const { const int L0 = i * G + c; if (L0 >= 2 * NCHH) return false;
        const int L = (L0 & 7) * (2 * NCHH / 8) + (L0 >> 3);
        const int ch = L >> 1, half = L & 1;
        u.pm = ch; u.pn = half; u.A = VT + ((size_t)ch * DV + half * 256) * LC * 2; u.B = KWT + (size_t)ch * DQK * LC * 2; u.A1 = nullptr; u.B1 = nullptr; u.O = CT + ((size_t)ch * DV + half * 256) * DQK * 2; return true; }
};
struct SchedNum {
    int G, c; const char* proj; const char* CT; const char* P; const char* VT; char* Y;
    __device__ __forceinline__ bool next(int i, pg8::Unit& u) const { const int L0 = i * G + c; if (L0 >= 2 * NCHH) return false;
        const int L = (L0 & 7) * (2 * NCHH / 8) + (L0 >> 3);
        const int ch = L >> 1, half = L & 1, bh = ch >> 5, cc = ch & 31, b = bh >> 2, h = bh & 3; const size_t row0 = (size_t)b * SEQ + cc * LC;
        u.pm = ch; u.pn = half; u.A = proj + (row0 * NPROJ + h * DQK) * 2; u.B = CT + ((size_t)ch * DV + half * 256) * DQK * 2;
        u.A1 = P + (size_t)ch * LC * LC * 2; u.B1 = VT + ((size_t)ch * DV + half * 256) * LC * 2; u.O = Y + (row0 * DM + h * DV + half * 256) * 2; return true; }
};
struct EpiNum : EpiStore {
    const float* SM;
    __device__ __forceinline__ void mid(pg8::f32x4 (&acc)[2][2][4][2], const pg8::Unit& u, int wr, int wc, int fr, int fq, PG8_LAS unsigned char* scr) const {
        const float* sm = SM + (size_t)u.pm * LC; const float mc = (u.pm & 31) ? sm[-1] : 0.f;
#pragma unroll
        for (int ai = 0; ai < 2; ++ai)
#pragma unroll
            for (int m = 0; m < 4; ++m) { const float r = SCALE_M * __expf(mc - sm[ai * 128 + wr * 64 + m * 16 + fr]);
#pragma unroll
                for (int bj = 0; bj < 2; ++bj)
#pragma unroll
                    for (int n = 0; n < 2; ++n) acc[ai][bj][m][n] *= r; }
    }
};

#define MP_DECODE(it_, ch_, isK_, sb_, db_, src_, dst_) do { ch_ = (it_) / 48; const int r_ = (it_) % 48, bh_ = ch_ >> 5, cc_ = ch_ & 31, b_ = bh_ >> 2, h_ = bh_ & 3; \
        const size_t row0_ = (size_t)b_ * SEQ + cc_ * LC; isK_ = r_ < 16; int colbase_; \
        if (isK_) { sb_ = r_ >> 2; db_ = r_ & 3; colbase_ = 1024 + h_ * DQK + db_ * 64; dst_ = KWT + ((size_t)ch_ * DQK + db_ * 64) * LC + sb_ * 64; } \
        else { const int r2_ = r_ - 16; sb_ = r2_ >> 3; db_ = r2_ & 7; colbase_ = 2048 + h_ * DV + db_ * 64; dst_ = VT + ((size_t)ch_ * DV + db_ * 64) * LC + sb_ * 64; } \
        src_ = PROJ + (row0_ + sb_ * 64 + sr) * NPROJ + colbase_ + 8 * dc; } while (0)
#define MP_STAGE(v_, ch_, isK_, sb_, db_, dst_) do { const float mend_ = SM[(size_t)ch_ * LC + LC - 1]; \
        _Pragma("unroll") for (int i = 0; i < 8; ++i) { const int s_ = sr + 8 * i; const float w_ = isK_ ? __expf(SA[(size_t)ch_ * LC + sb_ * 64 + s_] - mend_) : 1.0f; \
            LAS float* d_ = scr + s_ * 65 + 8 * dc; \
            d_[0] = bf_lo(v_[i].x) * w_; d_[1] = bf_hi(v_[i].x) * w_; d_[2] = bf_lo(v_[i].y) * w_; d_[3] = bf_hi(v_[i].y) * w_; d_[4] = bf_lo(v_[i].z) * w_; d_[5] = bf_hi(v_[i].z) * w_; d_[6] = bf_lo(v_[i].w) * w_; d_[7] = bf_hi(v_[i].w) * w_; } \
        LDS_WAIT(); \
        if (isK_) { float a_ = 0.f; _Pragma("unroll 16") for (int s2_ = 0; s2_ < 64; ++s2_) a_ += scr[s2_ * 65 + lane]; DNP[((size_t)ch_ * 4 + sb_) * DQK + db_ * 64 + lane] = a_; } \
        tr_out(scr, dst_, LC, lane); } while (0)
__device__ __forceinline__ void mp_phase(Frame& F) {
    const int lane = F.lane;
    LAS float* scr = (LAS float*)(F.lds + F.wave * TR_SCR);
    const bf16* PROJ = (const bf16*)(F.ka->ws + WS_PROJ); bf16* KWT = (bf16*)(F.ka->ws + WS_KWT); bf16* VT = (bf16*)(F.ka->ws + WS_H);
    const float* SA = (const float*)(F.ka->ws + WS_SA); const float* SM = (const float*)(F.ka->ws + WS_SM); float* DNP = (float*)(F.ka->ws + WS_DNP);
    const int gw = F.bid * NWAVES + F.wave, NGW = GRID * NWAVES;
    const int dc = lane & 7, sr = lane >> 3;
    for (int it = gw; it < NCHH * 48; it += 2 * NGW) {
        const int it2 = it + NGW; const bool two = it2 < NCHH * 48;
        int chA, sbA, dbA, chB = 0, sbB = 0, dbB = 0; bool kA, kB = false; const bf16 *srcA, *srcB = nullptr; bf16 *dstA, *dstB = nullptr;
        MP_DECODE(it, chA, kA, sbA, dbA, srcA, dstA);
        if (two) MP_DECODE(it2, chB, kB, sbB, dbB, srcB, dstB);
        v4u va[8], vb[8];
#pragma unroll
        for (int i = 0; i < 8; ++i) va[i] = *(const GAS v4u*)(srcA + (size_t)(8 * i) * NPROJ);
        if (two) {
#pragma unroll
            for (int i = 0; i < 8; ++i) vb[i] = *(const GAS v4u*)(srcB + (size_t)(8 * i) * NPROJ); }
        MP_STAGE(va, chA, kA, sbA, dbA, dstA);
        if (two) MP_STAGE(vb, chB, kB, sbB, dbB, dstB);
    }
}
#undef MP_DECODE
#undef MP_STAGE
__device__ __forceinline__ void mc_phase(Frame& F) {
    const float* SM = (const float*)(F.ka->ws + WS_SM);
    const int gtid = F.bid * NTHREADS + F.tid, NT = GRID * NTHREADS;
    for (int idx = gtid; idx < NBH * 16384; idx += NT) {
        const int bh = idx >> 14, vec = idx & 16383;
        const GAS v4u* p = (const GAS v4u*)((const char*)F.ka->out) + (size_t)bh * NCH * 16384 + vec;
        GAS v4u* q = (GAS v4u*)((char*)F.ka->out + OUT_CT2) + (size_t)bh * NCH * 16384 + vec;
        const float* me = SM + (size_t)bh * SEQ + LC - 1;
        float st[8];
#pragma unroll
        for (int e = 0; e < 8; ++e) st[e] = 0.f;
        float mprev = 0.f;
        for (int c0 = 0; c0 < NCH; c0 += 8) {
            v4u x[8];
#pragma unroll
            for (int j = 0; j < 8; ++j) x[j] = p[(size_t)(c0 + j) * 16384];
#pragma unroll
            for (int j = 0; j < 8; ++j) { const float mcur = me[(size_t)(c0 + j) * LC]; const float dec = __expf(mprev - mcur); mprev = mcur;
                v4u o; o.x = pk2(st[0], st[1]); o.y = pk2(st[2], st[3]); o.z = pk2(st[4], st[5]); o.w = pk2(st[6], st[7]);
                q[(size_t)(c0 + j) * 16384] = o;
                st[0] = st[0] * dec + bf_lo(x[j].x); st[1] = st[1] * dec + bf_hi(x[j].x); st[2] = st[2] * dec + bf_lo(x[j].y); st[3] = st[3] * dec + bf_hi(x[j].y);
                st[4] = st[4] * dec + bf_lo(x[j].z); st[5] = st[5] * dec + bf_hi(x[j].z); st[6] = st[6] * dec + bf_lo(x[j].w); st[7] = st[7] * dec + bf_hi(x[j].w); }
        }
    }
    const float* DNP = (const float*)(F.ka->ws + WS_DNP); float* NST = (float*)(F.ka->ws + WS_NST);
    const int gw = F.bid * NWAVES + F.wave, NGW = GRID * NWAVES;
    for (int task = gw; task < NBH * DQK; task += NGW) {
        const int bh = task >> 8, d = task & 255, c = F.lane & 31, ch = bh * NCH + c;
        const float* dp = DNP + (size_t)ch * 4 * DQK + d;
        const float dn = (dp[0] + dp[DQK]) + (dp[2 * DQK] + dp[3 * DQK]);
        const float* me = SM + (size_t)bh * SEQ + LC - 1;
        float n = 0.f, mprev = 0.f, nout = 0.f;
#pragma unroll
        for (int cc = 0; cc < NCH; ++cc) { const float mcur = me[(size_t)cc * LC]; const float dec = __expf(mprev - mcur); mprev = mcur;
            const float dnc = __builtin_bit_cast(float, __builtin_amdgcn_readlane(__builtin_bit_cast(int, dn), cc));
            nout = (c == cc) ? n : nout; n = n * dec + dnc; }
        if (F.lane < NCH) NST[(size_t)ch * DQK + d] = nout;
    }
}
__device__ __forceinline__ void mn_phase(Frame& F, const float* mnw  ) {
    const int lane = F.lane;
    const bf16* Y = (const bf16*)(F.ka->ws + WS_Y); bf16* YO = (bf16*)(F.ka->ws + WS_H); const bf16* PROJ = (const bf16*)(F.ka->ws + WS_PROJ); const bf16* P = (const bf16*)(F.ka->ws + WS_P);
    const float* NST = (const float*)(F.ka->ws + WS_NST); const float* SM = (const float*)(F.ka->ws + WS_SM); const float* SF = (const float*)(F.ka->ws + WS_SF);
    const int gw = F.bid * NWAVES + F.wave, rows_per = MROWS / (GRID * NWAVES);
    f32x4 w0[MH], w1[MH];
#pragma unroll
    for (int h = 0; h < MH; ++h) { w0[h] = *(const GAS f32x4*)(mnw + h * DV + 8 * lane); w1[h] = *(const GAS f32x4*)(mnw + h * DV + 8 * lane + 4); }
    const int rowA = gw * rows_per, bW = rowA >> 13, ccW = (rowA & (SEQ - 1)) >> 8;
    f32x4 nn[MH]; float mc[MH];
#pragma unroll
    for (int h = 0; h < MH; ++h) { const int bh = bW * MH + h, ch = bh * NCH + ccW;
        nn[h] = *(const GAS f32x4*)(NST + (size_t)ch * DQK + 4 * lane); mc[h] = ccW ? SM[(size_t)bh * SEQ + ccW * LC - 1] : 0.f; }
    v4u nuN[MH], ogN[MH]; v2u ppN[MH], qqN[MH]; float mtN[MH], ftN[MH];
#define MN_LOAD(row_) do { const int t_ = (row_) & (SEQ - 1), tl_ = t_ & 255; _Pragma("unroll") for (int h = 0; h < MH; ++h) { const int bh = bW * MH + h, ch = bh * NCH + ccW; \
            nuN[h] = *(const GAS v4u*)(Y + (size_t)(row_) * DM + h * DV + 8 * lane); ogN[h] = *(const GAS v4u*)(PROJ + (size_t)(row_) * NPROJ + 4096 + h * DV + 8 * lane); \
            ppN[h] = *(const GAS v2u*)(P + ((size_t)ch * LC + tl_) * LC + 4 * lane); qqN[h] = *(const GAS v2u*)(PROJ + (size_t)(row_) * NPROJ + h * DQK + 4 * lane); \
            mtN[h] = SM[(size_t)bh * SEQ + t_]; ftN[h] = SF[(size_t)bh * SEQ + t_]; } } while (0)
    MN_LOAD(rowA);
    for (int row = rowA; row < rowA + rows_per; ++row) {
        v4u nu[MH], og[MH]; v2u pp[MH], qq[MH]; float mt[MH], ft[MH];
#pragma unroll
        for (int h = 0; h < MH; ++h) { nu[h] = nuN[h]; og[h] = ogN[h]; pp[h] = ppN[h]; qq[h] = qqN[h]; mt[h] = mtN[h]; ft[h] = ftN[h]; }
        { const int rn_ = (row + 1 < rowA + rows_per) ? row + 1 : row; MN_LOAD(rn_); }
#pragma unroll
        for (int h = 0; h < MH; ++h) {
            float nv[8] = {bf_lo(nu[h].x), bf_hi(nu[h].x), bf_lo(nu[h].y), bf_hi(nu[h].y), bf_lo(nu[h].z), bf_hi(nu[h].z), bf_lo(nu[h].w), bf_hi(nu[h].w)};
            float ov[8] = {bf_lo(og[h].x), bf_hi(og[h].x), bf_lo(og[h].y), bf_hi(og[h].y), bf_lo(og[h].z), bf_hi(og[h].z), bf_lo(og[h].w), bf_hi(og[h].w)};
            float ps = (bf_lo(pp[h].x) + bf_hi(pp[h].x)) + (bf_lo(pp[h].y) + bf_hi(pp[h].y));
            float qn = (bf_lo(qq[h].x) * nn[h].x + bf_hi(qq[h].x) * nn[h].y) + (bf_lo(qq[h].y) * nn[h].z + bf_hi(qq[h].y) * nn[h].w);
            float sq = 0.f;
#pragma unroll
            for (int e = 0; e < 8; ++e) sq += nv[e] * nv[e];
            ps = wave_sum(ps); qn = wave_sum(qn); sq = wave_sum(sq);
            const float den = ps + SCALE_M * __expf(mc[h] - mt[h]) * qn;
            const float hden = fmaxf(fabsf(den), __expf(-(ft[h] + mt[h])));
            const float inv = 1.0f / hden;
            const float rr = rsqrtf(sq * inv * inv * (1.0f / DV) + EPS) * inv;
            const float wv[8] = {w0[h].x, w0[h].y, w0[h].z, w0[h].w, w1[h].x, w1[h].y, w1[h].z, w1[h].w};
            float yv[8];
#pragma unroll
            for (int e = 0; e < 8; ++e) yv[e] = nv[e] * rr * wv[e] * sigmoidf_(ov[e]);
            v4u o; o.x = pk2(yv[0], yv[1]); o.y = pk2(yv[2], yv[3]); o.z = pk2(yv[4], yv[5]); o.w = pk2(yv[6], yv[7]);
            *(GAS v4u*)(YO + (size_t)row * DM + h * DV + 8 * lane) = o;
        }
    }
#undef MN_LOAD
}

__device__ __forceinline__ void attn_phase(Frame& F, const int jf, const int rep) {
    char* lds = (char*)F.lds;
    const fa::bf16* PROJ = (const fa::bf16*)(F.ka->ws + WS_PROJ); fa::bf16* Y = (fa::bf16*)(F.ka->ws + WS_Y); const float* NB = (const float*)(F.ka->ws + WS_NB);
    constexpr int NQB = SEQ / fa::QB, TOTAL = NQB * BATCH * FH;
    static_assert(GRID <= TOTAL, "every workgroup owns a first item");
    unsigned* ctr = (unsigned*)(F.ka->ws + WS_CTL) + CW_Q + jf * 2 + rep;
    unsigned* kn = (unsigned*)(F.ka->ws + WS_CTL) + CW_KN + jf * 256;
    volatile LAS unsigned* MISC = (volatile LAS unsigned*)(F.lds + MISC_OFF);
#define FA_DECODE(I_, bh_, qb_) do { qb_ = NQB - 1 - ((I_) >> 6); bh_ = (I_) & 63; } while (0)
#define FA_REF(r_, bh_, qb_) do { const int b_ = (bh_) >> 4, h_ = (bh_) & 15; const size_t rb_ = (size_t)b_ * SEQ; \
        r_.Q = PROJ + (rb_ + (size_t)(qb_) * fa::QB) * NPROJ + h_ * 128; r_.K = PROJ + rb_ * NPROJ + 2048 + h_ * 128; r_.V = PROJ + rb_ * NPROJ + 4096 + h_ * 128; \
        r_.O = Y + (rb_ + (size_t)(qb_) * fa::QB) * DM + h_ * 128; r_.P0 = (qb_) * fa::QB; } while (0)
    int bh, qb; FA_DECODE(F.bid, bh, qb);
    fa::BlockRef cur; FA_REF(cur, bh, qb);
    fa::Seam S;
    fa::prime(cur, lds, S, F.tid);
    for (;;) {
        float k2 = 0.f;
        {
            int tb = F.tid; asm volatile("" : "+v"(tb));
            const GAS f32x4* src = (const GAS f32x4*)(NB + (size_t)bh * SEQ);
            LAS f32x4* dstb = (LAS f32x4*)(F.lds + fa::BIAS_OFF);
#pragma unroll
            for (int i = 0; i < 4; ++i) dstb[tb + i * NTHREADS] = src[tb + i * NTHREADS];
            if (tb == 0) MISC[32] = (unsigned)GRID + atomicAdd(ctr, 1u);
            const int rowq = cur.P0 + (tb >> 6) * fa::QBLK + (tb & 31);
            const GAS unsigned char* kr = (const GAS unsigned char*)cur.K + (size_t)rowq * (NPROJ * 2) + ((tb >> 5) & 1) * 16;
            const float nbi = *(const GAS float*)(NB + (size_t)bh * SEQ + rowq);
            float ss = 0.f, dd = 0.f;
#pragma unroll
            for (int d0 = 0; d0 < 8; ++d0) { const v4u w = *reinterpret_cast<const v4u*>(&S.qr[d0]); const v4u kw = *(const GAS v4u*)(kr + d0 * 32);
#pragma unroll
                for (int e = 0; e < 4; ++e) { const float lo = bf_lo(w[e]), hi = bf_hi(w[e]); ss = fmaf(lo, lo, ss); ss = fmaf(hi, hi, ss);
                    dd = fmaf(lo, bf_lo(kw[e]), dd); dd = fmaf(hi, bf_hi(kw[e]), dd); } }
            ss += __shfl_xor(ss, 32); dd += __shfl_xor(dd, 32);
            float vi = dd + nbi;
#pragma unroll
            for (int o = 1; o < 32; o <<= 1) { ss = fmaxf(ss, __shfl_xor(ss, o)); vi = fminf(vi, __shfl_xor(vi, o)); }
            if ((tb & 63) == 0) { MISC[40 + (tb >> 6)] = __float_as_uint(ss); MISC[48 + (tb >> 6)] = __float_as_uint(vi); }
#pragma unroll
            for (int w = 0; w < 4; ++w) k2 += __uint_as_float(__hip_atomic_load(kn + bh * 4 + w, RLX_AGENT));
            fa::head_issue(cur, lds, S, tb);
        }
        __syncthreads();
        const int nidx = __builtin_amdgcn_readfirstlane((int)MISC[32]);
        int T0;
        {
            float q2 = 0.f, vmin = __uint_as_float(MISC[48]);
#pragma unroll
            for (int w = 0; w < NWAVES; ++w) { q2 = fmaxf(q2, __uint_as_float(MISC[40 + w])); vmin = fminf(vmin, __uint_as_float(MISC[48 + w])); }
            const float TH = 1.02f * __builtin_sqrtf(q2 * k2) + (fa::THR / fa::SCALE + 128.0f / (1.4426950408889634f * fa::SCALE) + 2.0f);
            const LAS float* bl = (const LAS float*)(F.lds + fa::BIAS_OFF);
            const int ln = fa::lane_now(), NTL = (cur.P0 >> 6);
            const bool live0 = !(ln < NTL && vmin - bl[64 * ln + 63] > TH), live1 = !(ln + 64 < NTL && vmin - bl[64 * ln + 64 * 64 + 63] > TH);
            const unsigned long long b0 = __ballot(live0), b1 = __ballot(live1);
            T0 = b0 ? __builtin_ctzll(b0) : 64 + __builtin_ctzll(b1);
            T0 = __builtin_amdgcn_readfirstlane(T0);
        }
        const bool last = nidx >= TOTAL;
        int bhn = bh, qbn = qb;
        fa::BlockRef nxt; if (last) nxt = cur; else { FA_DECODE(nidx, bhn, qbn); FA_REF(nxt, bhn, qbn); }
        fa::block(cur, nxt, lds, S, F.tid, T0);
        if (last) break;
        cur = nxt; bh = bhn; qb = qbn;
    }
#undef FA_DECODE
#undef FA_REF
}

__device__ __forceinline__ void final_norm_phase(Frame& F) {
    const int lane = F.lane;
    const int gw = F.bid * NWAVES + F.wave, rows_per = MROWS / (GRID * NWAVES);
    f32x4 pw[8];
#pragma unroll
    for (int j = 0; j < 8; ++j) pw[j] = *(const GAS f32x4*)(F.ka->in[15] + 256 * j + 4 * lane);
    const unsigned short* X = (const unsigned short*)(F.ka->ws + WS_X);
    const int rA = gw * rows_per, rE = rA + rows_per;
    v2u a[8], b[8];
#pragma unroll
    for (int j = 0; j < 8; ++j) { a[j] = *(const GAS v2u*)(X + (size_t)rA * DM + 256 * j + 4 * lane); b[j] = *(const GAS v2u*)(X + (size_t)(rA + 1) * DM + 256 * j + 4 * lane); }
    for (int r = rA; r < rE; ++r) {
        const int rn = (r + 2 < rE) ? r + 2 : rE - 1;
        v2u c[8];
#pragma unroll
        for (int j = 0; j < 8; ++j) c[j] = *(const GAS v2u*)(X + (size_t)rn * DM + 256 * j + 4 * lane);
        f32x4 y[8]; float s = 0.f;
#pragma unroll
        for (int j = 0; j < 8; ++j) { y[j] = unpk_h4(a[j]); s += (y[j].x * y[j].x + y[j].y * y[j].y) + (y[j].z * y[j].z + y[j].w * y[j].w); }
        const float rs = rsqrtf(wave_sum(s) * (1.0f / DM) + EPS);
#pragma unroll
        for (int j = 0; j < 8; ++j) *(GAS f32x4*)(F.ka->out + (size_t)r * DM + 256 * j + 4 * lane) = y[j] * rs * pw[j];
#pragma unroll
        for (int j = 0; j < 8; ++j) { a[j] = b[j]; b[j] = c[j]; }
    }
}
#ifndef G4_AH
#define G4_AH 8
#endif
#ifndef G2_AH
#define G2_AH 8
#endif
#ifndef G3_WGM
#define G3_WGM 4
#endif
#ifndef WGM_RES
#define WGM_RES 4
#endif
constexpr int PH_PER_LAYER = 11, PH_FINAL = 1 + DEPTH * PH_PER_LAYER, PH_END = PH_FINAL + 1;
__global__ void __launch_bounds__(NTHREADS, 2) fwd(Args args) {
    extern __shared__ __attribute__((aligned(16))) unsigned char lds[];
    Frame F;
    F.lds = (LAS unsigned char*)lds;
    F.wave0 = __builtin_amdgcn_readfirstlane((int)threadIdx.x >> 6); refresh(F);
    volatile LAS unsigned* MISC = (volatile LAS unsigned*)(F.lds + MISC_OFF);
    for (int u = F.tid; u < 256; u += NTHREADS) MISC[u] = 0u;
    __syncthreads();
    XcdBarrier bar = xcd_barrier_post((unsigned*)(F.ka->ws + WS_CTL) + CW_BAR + args.li * XCD_BAR_WORDS, MISC + 8);
#ifndef PH_MASK
#define PH_MASK 0xFFFFFFFFu
#endif
#define EN(n) ((PH_MASK >> (n)) & 1u)
#ifndef REP_MASK
#define REP_MASK 0u
#endif
#define PHASE_BEGIN(n) _Pragma("unroll 1") for (int rep = 0; rep < (((REP_MASK >> (n)) & 1u) ? 2 : 1); ++rep) { if (rep) xcd_barrier(bar); refresh(F);
#define PHASE_END }
#define IN(k) (F.ka->ph_lo <= (k) && (k) < F.ka->ph_hi)
#define WS (F.ka->ws)
#define OUT (F.ka->out)
#define AIN(k) (F.ka->in[k])
#define SEAM(k, k2) do { if (IN(k) && IN(k2)) xcd_barrier(bar); } while (0)

    PHASE_BEGIN(0) if (EN(0) && IN(0)) { p0_prologue(F); } PHASE_END
    SEAM(0, 1);

    for (int l = 0; l < DEPTH; ++l) {
        const int pb = 1 + PH_PER_LAYER * l, j = l >> 1; const bool isM = (l & 1) == 0;
#define MOD_L ((const float*)(WS + WS_MOD) + (size_t)l * BATCH * MODW)
#define X16 ((char*)(WS + WS_X))
#define X16B ((char*)(WS + WS_X2))
#define Hb ((const char*)(WS + WS_H))
#define PROJb ((const char*)(WS + WS_PROJ))
#define Yb ((const char*)(WS + WS_Y))

        PHASE_BEGIN(1) if (EN(1) && IN(pb + 0)) {
            if (l == 0) norm_phase<8, true>(F, AIN(0), AIN(4) + (size_t)l * DM, MOD_L, 0, DM, (const float*)(WS + WS_WG) + (size_t)j * 8 * DM);
            else if (isM) norm_phase<8, false>(F, X16, AIN(4) + (size_t)l * DM, MOD_L, 0, DM, (const float*)(WS + WS_WG) + (size_t)j * 8 * DM);
            else norm_phase<16, false>(F, X16, AIN(4) + (size_t)l * DM, MOD_L, 0, DM, (const float*)(WS + WS_WGF) + (size_t)j * 16 * DM);
        } PHASE_END
        SEAM(pb + 0, pb + 1);

        PHASE_BEGIN(2) if (EN(2) && IN(pb + 1)) {
            if (isM) { if (F.bid < NBH) mlstm_gate_scan(F, F.bid, AIN(7) + j * 8); }
            else { if (F.bid < BATCH * FH) fox_gate_scan(F, F.bid, AIN(11) + j * 16); }
            __syncthreads();
            pg8::Gemm g{(unsigned)(DM * 2), (unsigned)(DM * 2), 0u, 0u, DM, 0};
            MainSched S; S.T.init(MROWS, NPROJ, GRID, F.bid); S.A = Hb;
            S.B = isM ? (const char*)(WS + WS_WINM) + (size_t)j * NPROJ * DM * 2 : (const char*)(WS + WS_WINF) + (size_t)j * NPROJ * DM * 2;
            S.O = (char*)(WS + WS_PROJ); S.tA = (size_t)256 * DM * 2; S.tB = (size_t)256 * DM * 2; S.tOm = (size_t)256 * NPROJ * 2; S.tOn = 256 * 2;
            EpiStore E; E.ldo = NPROJ; E.kn = isM ? nullptr : (unsigned*)(WS + WS_CTL) + CW_KN + j * 256;
            pg8::gemm_phase<EpiStore, MainSched, true, true, false>(F.lds, g, S, E, F.tid);
        } PHASE_END
        SEAM(pb + 1, pb + 2);

        if (isM) {
            PHASE_BEGIN(3) if (EN(3) && IN(pb + 2)) { mp_phase(F); } PHASE_END
            SEAM(pb + 2, pb + 3);
            PHASE_BEGIN(4) if (EN(4) && IN(pb + 3)) {
                { pg8::Gemm g{(unsigned)(NPROJ * 2), (unsigned)(NPROJ * 2), 0u, 0u, DQK, 0};
                  SchedS S; S.G = GRID; S.c = F.bid; S.proj = PROJb; S.P = (char*)(WS + WS_P);
                  EpiS E; E.SA = (const float*)(WS + WS_SA); E.SM = (const float*)(WS + WS_SM);
                  pg8::gemm_phase<EpiS, SchedS, true, true, false>(F.lds, g, S, E, F.tid); }
                { pg8::Gemm g{(unsigned)(LC * 2), (unsigned)(LC * 2), 0u, 0u, LC, 0};
                  SchedDC S; S.G = GRID; S.c = F.bid; S.VT = Hb; S.KWT = (const char*)(WS + WS_KWT); S.CT = (char*)OUT;
                  EpiStore E; E.ldo = DQK; E.kn = nullptr;
                  pg8::gemm_phase<EpiStore, SchedDC, true, true, false>(F.lds, g, S, E, F.tid); }
            } PHASE_END
            SEAM(pb + 3, pb + 4);
            PHASE_BEGIN(5) if (EN(5) && IN(pb + 4)) { mc_phase(F); } PHASE_END
            SEAM(pb + 4, pb + 5);
            PHASE_BEGIN(6) if (EN(6) && IN(pb + 5)) {
                pg8::Gemm g{(unsigned)(NPROJ * 2), (unsigned)(DQK * 2), (unsigned)(LC * 2), (unsigned)(LC * 2), DQK + LC, DQK / 64};
                SchedNum S; S.G = GRID; S.c = F.bid; S.proj = PROJb; S.CT = (const char*)OUT + OUT_CT2; S.P = (const char*)(WS + WS_P); S.VT = Hb; S.Y = (char*)(WS + WS_Y);
                EpiNum E; E.ldo = DM; E.SM = (const float*)(WS + WS_SM);
                pg8::gemm_phase<EpiNum, SchedNum, true, true, true>(F.lds, g, S, E, F.tid);
            } PHASE_END
            SEAM(pb + 5, pb + 6);
            PHASE_BEGIN(7) if (EN(7) && IN(pb + 6)) { mn_phase(F, AIN(8) + (size_t)j * DM); } PHASE_END
            SEAM(pb + 6, pb + 7);
        } else {
            PHASE_BEGIN(8) if (EN(8) && IN(pb + 2)) { attn_phase(F, j, rep); } PHASE_END
            SEAM(pb + 2, pb + 7);
        }

        PHASE_BEGIN(9) if (EN(9) && IN(pb + 7)) {
            pg8::Gemm g{(unsigned)(DM * 2), (unsigned)(DM * 2), 0u, 0u, DM, 0};
            MainSched S; S.T.init(MROWS, DM, GRID, F.bid, WGM_RES); S.A = isM ? Hb : Yb;
            S.B = isM ? (const char*)(WS + WS_WOUTM) + (size_t)j * DM * DM * 2 : (const char*)(WS + WS_WOUTF) + (size_t)j * DM * DM * 2;
            S.O = rep ? (char*)(WS + WS_KWT) : X16B; S.tA = (size_t)256 * DM * 2; S.tB = (size_t)256 * DM * 2; S.tOm = (size_t)256 * DM * 2; S.tOn = 256 * 2;
            if (l == 0 && !rep) { EpiResid<true> E; E.gate_l = MOD_L + 2 * DM; E.xin = AIN(0); pg8::gemm_phase<EpiResid<true>, MainSched, true, true, false>(F.lds, g, S, E, F.tid); }
            else { EpiResid<false, G2_AH> E; E.gate_l = MOD_L + 2 * DM; E.xin = X16; pg8::gemm_phase<EpiResid<false, G2_AH>, MainSched, true, true, false>(F.lds, g, S, E, F.tid); }
        } PHASE_END
        SEAM(pb + 7, pb + 8);

        PHASE_BEGIN(10) if (EN(10) && IN(pb + 8)) { norm_phase<0, false>(F, X16B, AIN(5) + (size_t)l * DM, MOD_L, 3 * DM, 4 * DM, nullptr); } PHASE_END
        SEAM(pb + 8, pb + 9);

        PHASE_BEGIN(11) if (EN(11) && IN(pb + 9)) {
            pg8::Gemm g{(unsigned)(DM * 2), (unsigned)(DM * 2), 0u, 0u, DM, 0};
            MainSched S; S.T.init(MROWS, 2 * DFF, GRID, F.bid, G3_WGM); S.A = Hb; S.B = (const char*)(WS + WS_WGU) + (size_t)l * 2 * DFF * DM * 2;
            S.O = (char*)(WS + WS_PROJ); S.tA = (size_t)256 * DM * 2; S.tB = (size_t)256 * DM * 2; S.tOm = (size_t)256 * DFF * 2; S.tOn = 128 * 2;
            EpiSwiglu E;
            pg8::gemm_phase<EpiSwiglu, MainSched, true, true, false>(F.lds, g, S, E, F.tid);
        } PHASE_END
        SEAM(pb + 9, pb + 10);

        PHASE_BEGIN(12) if (EN(12) && IN(pb + 10)) {
            pg8::Gemm g{(unsigned)(DFF * 2), (unsigned)(DFF * 2), 0u, 0u, DFF, 0};
            MainSched S; S.T.init(MROWS, DM, GRID, F.bid, WGM_RES, 1); S.A = PROJb; S.B = (const char*)(WS + WS_WDN) + (size_t)l * DM * DFF * 2;
            S.O = rep ? (char*)(WS + WS_KWT) : X16; S.tA = (size_t)256 * DFF * 2; S.tB = (size_t)256 * DFF * 2; S.tOm = (size_t)256 * DM * 2; S.tOn = 256 * 2;
            EpiResid<false, G4_AH> E; E.gate_l = MOD_L + 5 * DM; E.xin = X16B;
            pg8::gemm_phase<EpiResid<false, G4_AH>, MainSched, true, true, false>(F.lds, g, S, E, F.tid);
        } PHASE_END
        SEAM(pb + 10, pb + 11);
    }

    PHASE_BEGIN(13) if (EN(13) && IN(PH_FINAL)) { final_norm_phase(F); } PHASE_END
#undef IN
#undef WS
#undef OUT
#undef AIN
#undef MOD_L
#undef X16
#undef X16B
#undef Hb
#undef PROJb
#undef Yb
#undef SEAM
}

#ifndef MK_CUTS
#define MK_CUTS {0, PH_END}
#endif
extern "C" void kernel_launch(void* const* d_in, const int* in_sizes, int n_in, void* d_out, int out_size, void* d_ws, size_t ws_size, hipStream_t stream) {
    static int grid = 0;
    if (grid == 0) {
        if (n_in != 16 || in_sizes[0] != MROWS * DM || out_size != MROWS * DM || ws_size < WS_END) {
            fprintf(stderr, "kernel_launch: shape/workspace mismatch (n_in %d, in0 %d, out %d, ws %zu, need %zu); nothing launched\n", n_in, n_in > 0 ? in_sizes[0] : -1, out_size, ws_size, (size_t)WS_END); grid = -1; return; }
        int dev = 0, cus = 0, per_cu = 0;
        if (hipGetDevice(&dev) != hipSuccess || hipDeviceGetAttribute(&cus, hipDeviceAttributeMultiprocessorCount, dev) != hipSuccess) { grid = -1; return; }
        if (hipFuncSetAttribute((const void*)fwd, hipFuncAttributeMaxDynamicSharedMemorySize, LDS_BYTES) != hipSuccess) { fprintf(stderr, "kernel_launch: hipFuncSetAttribute failed\n"); grid = -1; return; }
        if (hipOccupancyMaxActiveBlocksPerMultiprocessor(&per_cu, (const void*)fwd, NTHREADS, LDS_BYTES) != hipSuccess || per_cu < 1) { fprintf(stderr, "kernel_launch: occupancy query says %d\n", per_cu); (void)hipGetLastError(); }
        if (cus != 256) { fprintf(stderr, "kernel_launch: built for 256 CUs, device has %d; nothing launched\n", cus); grid = -1; return; }
        grid = GRID;
    }
    if (grid < 0) return;
    if (hipMemsetAsync((char*)d_ws + WS_CTL, 0, CTL_ZERO_BYTES, stream) != hipSuccess) return;
    Args a{};
    for (int i = 0; i < 16; ++i) a.in[i] = (const float*)d_in[i];
    a.out = (float*)d_out; a.ws = (unsigned char*)d_ws; a.pad = 0;
    const int cuts[] = MK_CUTS; constexpr int ncut = sizeof(cuts) / sizeof(int);
    for (int li = 0; li + 1 < ncut; ++li) {
        a.ph_lo = cuts[li]; a.ph_hi = cuts[li + 1]; a.li = li;
        hipLaunchKernelGGL(fwd, dim3(grid), dim3(NTHREADS), LDS_BYTES, stream, a);
        const hipError_t le = hipPeekAtLastError();
        if (le != hipSuccess) { fprintf(stderr, "kernel_launch: launch %d failed: %s\n", li, hipGetErrorName(le)); break; }
    }
}
```

```cpp
#include <hip/hip_runtime.h>
#include <hip/hip_bf16.h>
#include <cstdio>
#include <cstdint>
#include <cstddef>
namespace pg8 {
#define PG8_LAS __attribute__((address_space(3)))
typedef unsigned short bf16_t;
typedef short bf16x8 __attribute__((ext_vector_type(8)));
typedef float f32x4 __attribute__((ext_vector_type(4)));
typedef float f32x2 __attribute__((ext_vector_type(2)));
typedef unsigned u32x4 __attribute__((ext_vector_type(4)));
constexpr int BM = 256, BK = 64, HALF = 128, HTB = HALF * BK * 2  , STAGE_BYTES = 8 * HTB, NXCD = 8, WGM = 4;

__host__ __device__ __forceinline__ int lds_byte(int r, int c) { const int st = (r >> 4) * 2 + (c >> 5), rr = r & 15, cc = c & 31, ob = rr * 64 + cc * 2; return st * 1024 + (ob ^ (((ob >> 9) & 1) << 5)); }
__host__ __device__ __forceinline__ void stage_rc(int b, int& R, int& C) { const int st = b / 1024, sb = b % 1024, swz = sb ^ (((sb >> 9) & 1) << 5); R = (st >> 1) * 16 + swz / 64; C = (st & 1) * 32 + (swz % 64) / 2; }
__host__ __device__ __forceinline__ int perm32(int rho) { const int n = rho >> 4, i = rho & 15; return 8 * (i >> 2) + 4 * n + (i & 3); }

struct Unit { const char* A; const char* B; const char* A1; const char* B1; char* O; int pm, pn; };
struct Gemm { unsigned lda, ldb, lda1, ldb1; int K, nt0; };

struct TileOrder {
    int nM, nN, nwg, G, c, wgm, rev;
    __device__ void init(int M, int N, int G_, int c_, int wgm_ = WGM, int rev_ = 0) { nM = M / BM; nN = N / BM; nwg = nM * nN; G = G_; c = c_; wgm = wgm_; rev = rev_; }
    __device__ bool tile(int i, int& pm, int& pn) const {
        const long L = (long)i * G + c; if (L >= nwg) return false;
        int wgid = (int)L; { const int q = nwg / NXCD, r = nwg % NXCD, xcd = wgid % NXCD, off = wgid / NXCD; wgid = (xcd < r ? xcd * (q + 1) : r * (q + 1) + (xcd - r) * q) + off; }
        if (rev) { const int q = nwg / NXCD, x = wgid / q; wgid = x * q + (q - 1 - (wgid - x * q)); }
        const int nig = wgm * nN, gid = wgid / nig, fm = gid * wgm, gsz = (nM - fm) < wgm ? (nM - fm) : wgm;
        pm = fm + ((wgid % nig) % gsz); pn = (wgid % nig) / gsz; return true;
    }
};

__device__ __forceinline__ unsigned cvt_pk_bf16(float lo, float hi) { unsigned r; asm volatile("v_cvt_pk_bf16_f32 %0, %1, %2" : "=v"(r) : "v"(lo), "v"(hi)); return r; }


template <class Epi, class Sched, bool ALIGN_EPI = false, bool SP2 = true, bool SPLIT = false>
__device__ __forceinline__ void gemm_phase(PG8_LAS unsigned char* lds, const Gemm g, const Sched& S, const Epi& E, const int tid  ) {
    const int wid = __builtin_amdgcn_readfirstlane(tid >> 6), lane = tid & 63, wr = wid >> 2, wc = wid & 3, fr = lane & 15, fq = lane >> 4;
    const int K = g.K, nt = K / BK;
    unsigned voffA[2], voffB[2], voffA1[2], voffB1[2];
#pragma unroll
    for (int i = 0; i < 2; ++i) { int R, C; stage_rc(tid * 16 + i * 8192, R, C); const int Rb = Epi::PERM ? ((R & ~31) + perm32(R & 31)) : R;
        voffA[i] = (unsigned)R * g.lda + (unsigned)C * 2u; voffB[i] = (unsigned)Rb * g.ldb + (unsigned)C * 2u;
        voffA1[i] = SPLIT ? (unsigned)R * g.lda1 + (unsigned)C * 2u : 0u; voffB1[i] = SPLIT ? (unsigned)Rb * g.ldb1 + (unsigned)C * 2u : 0u; }
    const size_t kstep = (size_t)(BK * 2);
    const unsigned hstepA = (unsigned)HALF * g.lda, hstepB = (unsigned)HALF * g.ldb;
    const unsigned hstepA1 = SPLIT ? (unsigned)HALF * g.lda1 : 0u, hstepB1 = SPLIT ? (unsigned)HALF * g.ldb1 : 0u;
    const unsigned ldsw = (unsigned)wid * 1024u;
    const int aoff = lds_byte(wr * 64 + fr, fq * 8), boff = lds_byte(wc * 32 + fr, fq * 8);
#define PG8_SA(b, h) (((b) * 2 + (h)) * HTB)
#define PG8_SB(b, h) ((4 + (b) * 2 + (h)) * HTB)
#define PG8_STAGE(bufoff, gbase, v0, v1) do { \
        __builtin_amdgcn_global_load_lds((const unsigned*)((const char*)(gbase) + (v0)), (PG8_LAS unsigned*)(lds + (bufoff) + ldsw), 16, 0, 0); \
        __builtin_amdgcn_global_load_lds((const unsigned*)((const char*)(gbase) + (v1)), (PG8_LAS unsigned*)(lds + (bufoff) + ldsw + 8192), 16, 0, 0); } while (0)
#define PG8_LDA(dst, b, h) do { _Pragma("unroll") for (int m = 0; m < 4; ++m) _Pragma("unroll") for (int k = 0; k < 2; ++k) dst[m][k] = *(const PG8_LAS bf16x8*)(lds + PG8_SA(b, h) + aoff + m * 2048 + k * 1024); } while (0)
#define PG8_LDB(dst, b, h) do { _Pragma("unroll") for (int n = 0; n < 2; ++n) _Pragma("unroll") for (int k = 0; k < 2; ++k) dst[n][k] = *(const PG8_LAS bf16x8*)(lds + PG8_SB(b, h) + boff + n * 2048 + k * 1024); } while (0)
#define PG8_MMA(ai, bj, At, Bt) do { __builtin_amdgcn_s_setprio(1); _Pragma("unroll") for (int m = 0; m < 4; ++m) _Pragma("unroll") for (int n = 0; n < 2; ++n) _Pragma("unroll") for (int k = 0; k < 2; ++k) \
        acc[ai][bj][m][n] = __builtin_amdgcn_mfma_f32_16x16x32_bf16(Bt[n][k], At[m][k], acc[ai][bj][m][n], 0, 0, 0); __builtin_amdgcn_s_setprio(0); } while (0)
#define PG8_WAIT_V(n) asm volatile("s_waitcnt vmcnt(" #n ")" ::: "memory")
#define PG8_WAIT_L(n) asm volatile("s_waitcnt lgkmcnt(" #n ")" ::: "memory")
#define PG8_BAR __builtin_amdgcn_s_barrier()
#define PG8_SCHED __builtin_amdgcn_sched_barrier(0)
    Unit cur, nxt; int ui = 0;
    if (!S.next(0, cur)) return;
    f32x4 acc[2][2][4][2];
#pragma unroll
    for (int a = 0; a < 2; ++a)
#pragma unroll
        for (int b = 0; b < 2; ++b)
#pragma unroll
            for (int m = 0; m < 4; ++m)
#pragma unroll
                for (int n = 0; n < 2; ++n) acc[a][b][m][n] = (f32x4){0.f, 0.f, 0.f, 0.f};
    bf16x8 At[4][2], B0[2][2], B1[2][2];
    const char* cA = cur.A; const char* cB = cur.B; const char* cA1 = SPLIT ? cur.A1 : nullptr; const char* cB1 = SPLIT ? cur.B1 : nullptr;
    if constexpr (SP2) {
        PG8_STAGE(PG8_SB(0, 0), cB, voffB[0], voffB[1]); PG8_STAGE(PG8_SB(0, 1), cB + hstepB, voffB[0], voffB[1]); PG8_STAGE(PG8_SA(0, 0), cA, voffA[0], voffA[1]); PG8_STAGE(PG8_SA(0, 1), cA + hstepA, voffA[0], voffA[1]);
        if (wr == 1) PG8_BAR;
        PG8_WAIT_V(2); PG8_BAR;
        PG8_STAGE(PG8_SB(1, 0), cB + kstep, voffB[0], voffB[1]); PG8_STAGE(PG8_SA(1, 0), cA + kstep, voffA[0], voffA[1]); PG8_STAGE(PG8_SB(1, 1), cB + hstepB + kstep, voffB[0], voffB[1]);
        PG8_WAIT_V(6); PG8_BAR;
    } else {
        PG8_STAGE(PG8_SB(0, 0), cB, voffB[0], voffB[1]); PG8_STAGE(PG8_SA(0, 0), cA, voffA[0], voffA[1]); PG8_STAGE(PG8_SB(0, 1), cB + hstepB, voffB[0], voffB[1]); PG8_STAGE(PG8_SA(0, 1), cA + hstepA, voffA[0], voffA[1]);
        if (wr == 1) PG8_BAR;
        PG8_WAIT_V(4); PG8_BAR;
        PG8_STAGE(PG8_SB(1, 0), cB + kstep, voffB[0], voffB[1]); PG8_STAGE(PG8_SA(1, 0), cA + kstep, voffA[0], voffA[1]); PG8_STAGE(PG8_SB(1, 1), cB + hstepB + kstep, voffB[0], voffB[1]);
        PG8_WAIT_V(6); PG8_BAR;
    }
    for (;;) {
        const bool has_next = S.next(ui + 1, nxt);
        const char* nA = has_next ? nxt.A : cA; const char* nB = has_next ? nxt.B : cB;
#pragma unroll 1
        for (int t = 0; t < nt; t += 2) {
            const bool last = (t == nt - 2);
            const char *a1, *a2, *b2; unsigned hA1, hA2, hB2; unsigned vA1_0, vA1_1, vA2_0, vA2_1, vB2_0, vB2_1;
            if constexpr (SPLIT) {
                const bool s1 = (t + 1) < g.nt0, s2 = last || (t + 2) < g.nt0;
                a1 = s1 ? cA + (size_t)(t + 1) * kstep : cA1 + (size_t)(t + 1 - g.nt0) * kstep; hA1 = s1 ? hstepA : hstepA1; vA1_0 = s1 ? voffA[0] : voffA1[0]; vA1_1 = s1 ? voffA[1] : voffA1[1];
                a2 = last ? nA : (s2 ? cA + (size_t)(t + 2) * kstep : cA1 + (size_t)(t + 2 - g.nt0) * kstep);
                b2 = last ? nB : (s2 ? cB + (size_t)(t + 2) * kstep : cB1 + (size_t)(t + 2 - g.nt0) * kstep);
                hA2 = s2 ? hstepA : hstepA1; hB2 = s2 ? hstepB : hstepB1;
                vA2_0 = s2 ? voffA[0] : voffA1[0]; vA2_1 = s2 ? voffA[1] : voffA1[1]; vB2_0 = s2 ? voffB[0] : voffB1[0]; vB2_1 = s2 ? voffB[1] : voffB1[1];
                if (t == g.nt0) { int le = lane; asm volatile("" : "+v"(le)); E.mid(acc, cur, wr, wc, le & 15, le >> 4, nullptr); }
            } else {
                a1 = cA + (size_t)(t + 1) * kstep; hA1 = hstepA; vA1_0 = voffA[0]; vA1_1 = voffA[1];
                a2 = last ? nA : cA + (size_t)(t + 2) * kstep; b2 = last ? nB : cB + (size_t)(t + 2) * kstep; hA2 = hstepA; hB2 = hstepB;
                vA2_0 = voffA[0]; vA2_1 = voffA[1]; vB2_0 = voffB[0]; vB2_1 = voffB[1];
            }
            const char* a3 = a2 + kstep; const char* b3 = b2 + kstep;
            if constexpr (SP2) {
            PG8_LDB(B0, 0, 0); PG8_LDB(B1, 0, 1); PG8_SCHED; PG8_LDA(At, 0, 0); PG8_STAGE(PG8_SA(1, 1), a1 + hA1, vA1_0, vA1_1);
            PG8_WAIT_V(8); PG8_WAIT_L(0); PG8_BAR; PG8_MMA(0, 0, At, B0); PG8_MMA(0, 1, At, B1); PG8_BAR; PG8_SCHED;
            PG8_LDA(At, 0, 1); PG8_STAGE(PG8_SB(0, 0), b2, vB2_0, vB2_1); PG8_STAGE(PG8_SB(0, 1), b2 + hB2, vB2_0, vB2_1); PG8_STAGE(PG8_SA(0, 0), a2, vA2_0, vA2_1);
            PG8_WAIT_V(8); PG8_WAIT_L(0); PG8_BAR; PG8_MMA(1, 0, At, B0); PG8_MMA(1, 1, At, B1); PG8_BAR; PG8_SCHED;
            PG8_LDB(B0, 1, 0); PG8_LDB(B1, 1, 1); PG8_SCHED; PG8_LDA(At, 1, 0); PG8_STAGE(PG8_SA(0, 1), a2 + hA2, vA2_0, vA2_1);
            PG8_WAIT_V(8); PG8_WAIT_L(0); PG8_BAR; PG8_MMA(0, 0, At, B0); PG8_MMA(0, 1, At, B1); PG8_BAR; PG8_SCHED;
            PG8_LDA(At, 1, 1); PG8_STAGE(PG8_SB(1, 0), b3, vB2_0, vB2_1); PG8_STAGE(PG8_SB(1, 1), b3 + hB2, vB2_0, vB2_1); PG8_STAGE(PG8_SA(1, 0), a3, vA2_0, vA2_1);
            PG8_WAIT_V(8); PG8_WAIT_L(0); PG8_BAR; PG8_MMA(1, 0, At, B0); PG8_MMA(1, 1, At, B1); PG8_BAR; PG8_SCHED;
            } else {
            PG8_LDB(B0, 0, 0); PG8_SCHED; PG8_LDA(At, 0, 0); PG8_STAGE(PG8_SA(1, 1), a1 + hA1, vA1_0, vA1_1);
            PG8_WAIT_L(8); PG8_BAR; PG8_WAIT_L(0); PG8_MMA(0, 0, At, B0); PG8_BAR; PG8_SCHED;
            PG8_LDB(B1, 0, 1); PG8_STAGE(PG8_SB(0, 0), b2, vB2_0, vB2_1);
            PG8_BAR; PG8_WAIT_L(0); PG8_MMA(0, 1, At, B1); PG8_BAR;
            PG8_LDA(At, 0, 1); PG8_STAGE(PG8_SA(0, 0), a2, vA2_0, vA2_1);
            PG8_BAR; PG8_WAIT_L(0); PG8_MMA(1, 0, At, B0); PG8_BAR; PG8_SCHED;
            PG8_STAGE(PG8_SB(0, 1), b2 + hB2, vB2_0, vB2_1);
            PG8_WAIT_V(6); PG8_BAR; PG8_MMA(1, 1, At, B1); PG8_BAR;
            PG8_LDB(B0, 1, 0); PG8_SCHED; PG8_LDA(At, 1, 0); PG8_STAGE(PG8_SA(0, 1), a2 + hA2, vA2_0, vA2_1);
            PG8_WAIT_L(8); PG8_BAR; PG8_WAIT_L(0); PG8_MMA(0, 0, At, B0); PG8_BAR; PG8_SCHED;
            PG8_LDB(B1, 1, 1); PG8_STAGE(PG8_SB(1, 0), b3, vB2_0, vB2_1);
            PG8_BAR; PG8_WAIT_L(0); PG8_MMA(0, 1, At, B1); PG8_BAR;
            PG8_LDA(At, 1, 1); PG8_STAGE(PG8_SA(1, 0), a3, vA2_0, vA2_1);
            PG8_BAR; PG8_WAIT_L(0); PG8_MMA(1, 0, At, B0); PG8_BAR; PG8_SCHED;
            PG8_STAGE(PG8_SB(1, 1), b3 + hB2, vB2_0, vB2_1);
            PG8_WAIT_V(6); PG8_BAR; PG8_MMA(1, 1, At, B1); PG8_BAR;
            }
        }
        if constexpr (ALIGN_EPI) { if (wr == 0) PG8_BAR; }
        { int le = lane; asm volatile("" : "+v"(le)); E(acc, cur, wr, wc, le & 15, le >> 4, lds + PG8_SA(1, 1) + ldsw); }
        if (!has_next) break;
#pragma unroll
        for (int a = 0; a < 2; ++a)
#pragma unroll
            for (int b = 0; b < 2; ++b)
#pragma unroll
                for (int m = 0; m < 4; ++m)
#pragma unroll
                    for (int n = 0; n < 2; ++n) acc[a][b][m][n] = (f32x4){0.f, 0.f, 0.f, 0.f};
        cur = nxt; cA = nA; cB = nB; if constexpr (SPLIT) { cA1 = cur.A1; cB1 = cur.B1; } ++ui;
        if constexpr (ALIGN_EPI) { if (wr == 1) PG8_BAR; }
    }
    PG8_WAIT_V(0);
    if constexpr (!ALIGN_EPI) { if (wr == 0) PG8_BAR; }
    PG8_BAR;
#undef PG8_SA
#undef PG8_SB
#undef PG8_STAGE
#undef PG8_LDA
#undef PG8_LDB
#undef PG8_MMA
#undef PG8_WAIT_V
#undef PG8_WAIT_L
#undef PG8_BAR
#undef PG8_SCHED
}
}
namespace fa {
using bf16 = __hip_bfloat16;
typedef short bf16x8 __attribute__((ext_vector_type(8)));
typedef short s16x4 __attribute__((ext_vector_type(4)));
typedef float f32x16 __attribute__((ext_vector_type(16)));
typedef float f32x4 __attribute__((ext_vector_type(4)));
typedef unsigned u32x4 __attribute__((ext_vector_type(4)));
constexpr int D = 128;
constexpr int QPITCH = 6144, OPITCH = 2048;
constexpr float SCALE = 0.08838834764831845f;
constexpr float THR = 4.f;
constexpr int NW = 8, QBLK = 32, KVBLK = 64, QB = NW * QBLK;
constexpr int SHM_V = KVBLK * D * 2, SHM_K = KVBLK * D * 2;
constexpr int NBUF = 3;
constexpr int BIAS_OFF = NBUF * SHM_V + NBUF * SHM_K + NW * 64 * 4;
constexpr int LDS_BYTES = BIAS_OFF + 8192 * 4;

#define KSWZ(row, colB) ((row) * 256 + ((colB) ^ (((row) & 7) << 4)))
#define SBAR() __builtin_amdgcn_sched_barrier(0)
__device__ __forceinline__ int v_st(int k, int c) { const int kk = (k & ~0xC) | ((k & 4) << 1) | ((k & 8) >> 1); return ((kk >> 3) * 4 + (c >> 5)) * 512 + ((kk & 7) * 32 + (c & 31)) * 2; }
__device__ __forceinline__ int v_rd_base(int lane) { return ((lane & 3) << 3) | (((lane >> 2) & 3) << 6) | (((lane >> 4) & 1) << 5) | (((lane >> 5) & 1) << 8); }
constexpr int v_rd_off(int d0, int ks, int half) { return d0 * 512 + ks * 4096 + half * 2048; }
__device__ __forceinline__ int lane_now() { int t; asm volatile("v_mbcnt_lo_u32_b32 %0, -1, 0\n\tv_mbcnt_hi_u32_b32 %0, -1, %0" : "=v"(t)); return t; }
__device__ __forceinline__ int crow(int r, int hi) { return (r & 3) + 8 * (r >> 2) + 4 * hi; }
__device__ __forceinline__ unsigned cvtpk(float lo, float hi) { unsigned r; asm volatile("v_cvt_pk_bf16_f32 %0, %1, %2" : "=v"(r) : "v"(lo), "v"(hi)); return r; }
__device__ __forceinline__ bf16x8 load8(const bf16* p) { return *reinterpret_cast<const bf16x8*>(p); }
__device__ __forceinline__ void mask_tile(f32x16& p0, f32x16& p1, int dq) {
    const float NEG = -__builtin_inff();
#pragma unroll
    for (int r = 0; r < 16; ++r) {
        const int c = (r & 3) + 8 * (r >> 2);
        if (dq - c < 0) p0[r] = NEG;
        if (dq - c - 32 < 0) p1[r] = NEG;
    }
}
__device__ __forceinline__ bool partialSM(f32x16& p0, f32x16& p1, float& m_reg, float& mn, float& alpha) {
    float pmax = p0[0]; for (int r = 1; r < 16; ++r) pmax = fmaxf(pmax, p0[r]); for (int r = 0; r < 16; ++r) pmax = fmaxf(pmax, p1[r]);
    { auto rr = __builtin_amdgcn_permlane32_swap(__float_as_uint(pmax), __float_as_uint(pmax), false, false);
      pmax = fmaxf(__uint_as_float(rr[0]), __uint_as_float(rr[1])); }
    constexpr float C2 = 1.4426950408889634f * SCALE;
    if (__all((pmax - m_reg) * C2 < -127.f)) { mn = m_reg; alpha = 1.f; return true; }
    if (__builtin_expect(__all((pmax - m_reg) * SCALE <= THR), 1)) { mn = m_reg; alpha = 1.f; }
    else { mn = fmaxf(m_reg, pmax); alpha = __builtin_amdgcn_exp2f((m_reg - mn) * C2); m_reg = mn; }
    const float mnL = -mn * C2;
    for (int r = 0; r < 16; ++r) p0[r] = fmaf(p0[r], C2, mnL); for (int r = 0; r < 16; ++r) p1[r] = fmaf(p1[r], C2, mnL);
    for (int r = 0; r < 16; ++r) p0[r] = __builtin_amdgcn_exp2f(p0[r]);
    return false;
}
__device__ __forceinline__ void finishSM(f32x16& p0, f32x16& p1, float alpha, float& l_reg, bf16x8& pa0, bf16x8& pa1, bf16x8& pa2, bf16x8& pa3, const bool dead = false) {
    for (int r = 0; r < 16; ++r) p1[r] = __builtin_amdgcn_exp2f(p1[r]);
    float ps = 0; for (int r = 0; r < 16; ++r) ps += p0[r]; for (int r = 0; r < 16; ++r) ps += p1[r];
    { auto rr = __builtin_amdgcn_permlane32_swap(__float_as_uint(ps), __float_as_uint(ps), false, false);
      ps = __uint_as_float(rr[0]) + __uint_as_float(rr[1]); }
    l_reg = dead ? l_reg : l_reg * alpha + ps;
#define PK4(P, B_, OUT) do { unsigned a0 = cvtpk(P[B_+0], P[B_+1]), a1 = cvtpk(P[B_+2], P[B_+3]);                          \
        unsigned b0 = cvtpk(P[B_+4], P[B_+5]), b1 = cvtpk(P[B_+6], P[B_+7]);                                             \
        auto r0 = __builtin_amdgcn_permlane32_swap(a0, b0, false, false); auto r1 = __builtin_amdgcn_permlane32_swap(a1, b1, false, false); \
        u32x4 w = {r0[0], r1[0], r0[1], r1[1]}; OUT = *reinterpret_cast<bf16x8*>(&w); } while (0)
    PK4(p0, 0, pa0); PK4(p0, 8, pa1); PK4(p1, 0, pa2); PK4(p1, 8, pa3);
#undef PK4
}
__device__ __forceinline__ void qkt(int KB, f32x16& p0, f32x16& p1, const char* K_lds, int r32, int hi, const bf16x8* qr, const char* bias_t) {
    { const int ln_ = lane_now(); bias_t += ((ln_ >> 5) << 4);
#pragma unroll
      for (int g4 = 0; g4 < 4; ++g4) { const f32x4 b0 = *reinterpret_cast<const f32x4*>(bias_t + g4 * 32); const f32x4 b1 = *reinterpret_cast<const f32x4*>(bias_t + 128 + g4 * 32);
        p0[4 * g4 + 0] = b0[0]; p0[4 * g4 + 1] = b0[1]; p0[4 * g4 + 2] = b0[2]; p0[4 * g4 + 3] = b0[3];
        p1[4 * g4 + 0] = b1[0]; p1[4 * g4 + 1] = b1[1]; p1[4 * g4 + 2] = b1[2]; p1[4 * g4 + 3] = b1[3]; } }
    unsigned k0a = (unsigned)(uintptr_t)K_lds + (unsigned)(KB * SHM_K) + (unsigned)KSWZ(r32, hi * 16);
    asm volatile("" : "+v"(k0a));
    const char* kb[4];
#pragma unroll
    for (int dd = 0; dd < 4; ++dd) kb[dd] = (const char*)(__attribute__((address_space(3))) const char*)(uintptr_t)(k0a ^ (unsigned)(dd << 5));
#pragma unroll
    for (int d0 = 0; d0 < 8; ++d0) { const char* a = kb[d0 & 3] + (d0 >> 2) * 128;
        bf16x8 b0 = *reinterpret_cast<const bf16x8*>(a);
        bf16x8 b1 = *reinterpret_cast<const bf16x8*>(a + 32 * 256);
        p0 = __builtin_amdgcn_mfma_f32_32x32x16_bf16(b0, qr[d0], p0, 0, 0, 0);
        p1 = __builtin_amdgcn_mfma_f32_32x32x16_bf16(b1, qr[d0], p1, 0, 0, 0); }
}
__device__ __forceinline__ void add_bias(f32x16& p0, f32x16& p1, const char* bias_t) {
#pragma unroll
    for (int g4 = 0; g4 < 4; ++g4) { const f32x4 b0 = *reinterpret_cast<const f32x4*>(bias_t + g4 * 32);
        p0[4 * g4 + 0] += b0[0]; p0[4 * g4 + 1] += b0[1]; p0[4 * g4 + 2] += b0[2]; p0[4 * g4 + 3] += b0[3]; }
#pragma unroll
    for (int g4 = 0; g4 < 4; ++g4) { const f32x4 b1 = *reinterpret_cast<const f32x4*>(bias_t + 128 + g4 * 32);
        p1[4 * g4 + 0] += b1[0]; p1[4 * g4 + 1] += b1[1]; p1[4 * g4 + 2] += b1[2]; p1[4 * g4 + 3] += b1[3]; }
}
__device__ __forceinline__ void pv_tile(int VB, f32x16* o, int vb0, bf16x8 pa0, bf16x8 pa1, bf16x8 pa2, bf16x8 pa3) {
    const int vbt = vb0 + VB * SHM_V;
#define TRRD(dst, off) asm volatile("ds_read_b64_tr_b16 %0, %1 offset:%2" : "=&v"(dst) : "v"(vbt), "i"(off) : "memory")
#define PV_D0(d0) do { s16x4 l0, l1, l2, l3, h0, h1, h2, h3; constexpr int b_ = v_rd_off(d0, 0, 0);     \
        TRRD(l0, b_); TRRD(h0, b_ + 2048); TRRD(l1, b_ + 4096); TRRD(h1, b_ + 6144); TRRD(l2, b_ + 8192); TRRD(h2, b_ + 10240); TRRD(l3, b_ + 12288); TRRD(h3, b_ + 14336); \
        asm volatile("s_waitcnt lgkmcnt(0)" ::: "memory"); SBAR();   \
        o[d0] = __builtin_amdgcn_mfma_f32_32x32x16_bf16(pa0, (bf16x8){l0[0], l0[1], l0[2], l0[3], h0[0], h0[1], h0[2], h0[3]}, o[d0], 0, 0, 0);   \
        o[d0] = __builtin_amdgcn_mfma_f32_32x32x16_bf16(pa1, (bf16x8){l1[0], l1[1], l1[2], l1[3], h1[0], h1[1], h1[2], h1[3]}, o[d0], 0, 0, 0);   \
        o[d0] = __builtin_amdgcn_mfma_f32_32x32x16_bf16(pa2, (bf16x8){l2[0], l2[1], l2[2], l2[3], h2[0], h2[1], h2[2], h2[3]}, o[d0], 0, 0, 0);   \
        o[d0] = __builtin_amdgcn_mfma_f32_32x32x16_bf16(pa3, (bf16x8){l3[0], l3[1], l3[2], l3[3], h3[0], h3[1], h3[2], h3[3]}, o[d0], 0, 0, 0); } while (0)
    PV_D0(0); PV_D0(1); PV_D0(2); PV_D0(3);
#undef PV_D0
#undef TRRD
}

struct BlockRef { const bf16* Q; const bf16* K; const bf16* V; bf16* O; int P0; };
struct Seam { bf16x8 qr[8]; bf16x8 st_v0, st_v1, st_k0, st_k1; };
#define KVROW(p, k0, rr) ((const char*)(p) + (size_t)((k0) + (rr)) * (QPITCH * 2))
#define VMW() asm volatile("s_waitcnt vmcnt(0)" ::: "memory")
#define VMWN(n) asm volatile("s_waitcnt vmcnt(%0)" :: "i"(n) : "memory")
#define SLOAD_H(Kp, Vp, k0) do { S.st_v0 = *(const bf16x8*)(KVROW(Vp, k0, 0) + voffKV); S.st_v1 = *(const bf16x8*)(KVROW(Vp, k0, 32) + voffKV);              \
                         S.st_k0 = *(const bf16x8*)(KVROW(Kp, k0, 0) + voffKV); S.st_k1 = *(const bf16x8*)(KVROW(Kp, k0, 32) + voffKV); } while (0)
#define SWRITE_HK(bf) do { *(bf16x8*)(K_lds + (bf) * SHM_K + kws) = S.st_k0; *(bf16x8*)(K_lds + (bf) * SHM_K + kws + 32 * 256) = S.st_k1; } while (0)
#define SWRITE_HV(bf) do { *(bf16x8*)(V_lds + (bf) * SHM_V + vst0) = S.st_v0; *(bf16x8*)(V_lds + (bf) * SHM_V + vst1) = S.st_v1; } while (0)
#define SWRITE_H(bf) do { SWRITE_HV(bf); SWRITE_HK(bf); } while (0)
__device__ __forceinline__ void prime(const BlockRef& cur, char* lds, Seam& S, const int tid) {
    const int wid = __builtin_amdgcn_readfirstlane(tid >> 6), lane = tid & 63, r32 = lane & 31, hi = lane >> 5;
    const int sr = tid >> 4, sc = (tid & 15) * 8, kws = KSWZ(sr, sc * 2); char* K_lds = lds + NBUF * SHM_V;
    const unsigned voffKV = (unsigned)((sr * QPITCH + sc) * 2), voffQ = (unsigned)((r32 * QPITCH + hi * 8) * 2);
    { const char* qb = (const char*)cur.Q + (size_t)(wid * QBLK) * (QPITCH * 2);
#pragma unroll
      for (int d0 = 0; d0 < 8; ++d0) S.qr[d0] = *(const bf16x8*)(qb + d0 * 32 + voffQ); }
    SLOAD_H(cur.K, cur.V, (cur.P0 + QB - 1) / KVBLK * KVBLK); VMW(); SWRITE_HK(0);
    __syncthreads();
}
__device__ __forceinline__ void head_issue(const BlockRef& cur, char* lds, Seam& S, const int tid) {
    const int sr = tid >> 4, sc = (tid & 15) * 8, vst0 = v_st(sr, sc), vst1 = vst0 + 8192; char* V_lds = lds;
    const unsigned voffKV = (unsigned)((sr * QPITCH + sc) * 2);
    SWRITE_HV(0); SBAR();
    SLOAD_H(cur.K, cur.V, cur.P0 + QB - 2 * KVBLK); SBAR();
}
__device__ __forceinline__ void block(const BlockRef& cur, const BlockRef& nxt, char* lds, Seam& S, const int tid, const int T0) {
    const int wid = __builtin_amdgcn_readfirstlane(tid >> 6), lane = tid & 63, r32 = lane & 31, hi = lane >> 5;
    const int NTF = (cur.P0 + QB - 1) / KVBLK + 1;
    const int NT = NTF - T0;
    const int qlo = cur.P0 + wid * QBLK;
    char* V_lds = lds; char* K_lds = lds + NBUF * SHM_V;
    float* ws = (float*)(lds + NBUF * SHM_V + NBUF * SHM_K) + wid * 64; float* li_l = ws, * al_l = ws + 32;
    const char* bias_b = lds + BIAS_OFF;
    float m_reg = -1e30f, l_reg = 0; f32x16 o[4] = {};
    const int sr = tid >> 4, sc = (tid & 15) * 8, vst0 = v_st(sr, sc), vst1 = vst0 + 8192  , kws = KSWZ(sr, sc * 2);
    const int vb0 = (int)(uintptr_t)V_lds + v_rd_base(lane);
    const unsigned voffKV = (unsigned)((sr * QPITCH + sc) * 2), voffQ = (unsigned)((r32 * QPITCH + hi * 8) * 2);
    const bf16* Kh = cur.K; const bf16* Vh = cur.V;
#define RESC(a) do { if (__any((a) < 1.f)) { if (hi == 0) al_l[r32] = (a); asm volatile("s_waitcnt lgkmcnt(0)" ::: "memory");              \
                     for (int d_ = 0; d_ < 4; ++d_) for (int r = 0; r < 16; ++r) o[d_][r] *= al_l[crow(r, hi)]; } } while (0)
#define KBASE(t) ((NTF - 1 - (t)) * KVBLK)
#define MASKT(P0_, P1_, t) do { const int kb_ = KBASE(t); const int ln_ = lane_now(); \
        if (kb_ + KVBLK - 1 > qlo) mask_tile(P0_, P1_, qlo + (ln_ & 31) - 4 * (ln_ >> 5) - kb_); } while (0)
    constexpr int NQL = 8;
#define SEAM_K0() do { VMWN(NQL); SWRITE_HK(0); SBAR(); } while (0)
    f32x16 pA0, pA1, pB0, pB1; float mnA, mnB, alA, alB; bf16x8 pa0, pa1, pa2, pa3;
    SBAR(); qkt(0, pA0, pA1, K_lds, r32, hi, S.qr, bias_b + KBASE(0) * 4);
    bool deadA, deadB = true;
    MASKT(pA0, pA1, 0); deadA = partialSM(pA0, pA1, m_reg, mnA, alA);
    if (NT > 1) { VMW(); SWRITE_H(1); }
    __syncthreads();
#define HALF_STEP(PX0, PX1, mnX, alX, dX, PY0, PY1, alY, dY, t) do {                                                           \
        const int vbi_ = bt == 0 ? 2 : bt - 1, sbi_ = bt == 2 ? 0 : bt + 1;                                                    \
        SBAR();                                                                                                               \
        qkt(bt, PX0, PX1, K_lds, r32, hi, S.qr, bias_b + KBASE(t) * 4);                                                       \
        finishSM(PY0, PY1, alY, l_reg, pa0, pa1, pa2, pa3, dY);                                                              \
        SBAR();                                                                                                               \
        if ((t) + 1 < NT) { SLOAD_H(Kh, Vh, KBASE((t) + 1)); SBAR(); }                                                        \
        if (!(dY)) pv_tile(vbi_, o, vb0, pa0, pa1, pa2, pa3);                                                                 \
        MASKT(PX0, PX1, (t)); dX = partialSM(PX0, PX1, m_reg, mnX, alX);                                                      \
        if ((t) + 1 < NT) { VMW(); SWRITE_H(sbi_); }                                                                          \
        RESC(alX); __syncthreads(); bt = sbi_; } while (0)
    int bt = 1;
    for (int t = 1; t + 1 < NT; t += 2) {
        HALF_STEP(pB0, pB1, mnB, alB, deadB, pA0, pA1, alA, deadA, t);
        HALF_STEP(pA0, pA1, mnA, alA, deadA, pB0, pB1, alB, deadB, t + 1);
    }
    const bool even = (NT & 1) == 0;
    const int vba = bt == 0 ? 2 : bt - 1;
    if (even) { SBAR(); qkt(bt, pB0, pB1, K_lds, r32, hi, S.qr, bias_b + KBASE(NT - 1) * 4); SBAR(); }
    SLOAD_H(nxt.K, nxt.V, (nxt.P0 + QB - 1) / KVBLK * KVBLK); SBAR();
    { int tq = tid; asm volatile("" : "+v"(tq));
      const unsigned voffQ = (unsigned)((((tq & 31) * QPITCH) + ((tq >> 5) & 1) * 8) * 2);
      const char* qb = (const char*)nxt.Q + (size_t)(wid * QBLK) * (QPITCH * 2);
#pragma unroll
      for (int d0 = 0; d0 < 8; ++d0) S.qr[d0] = *(const bf16x8*)(qb + d0 * 32 + voffQ); }
    SBAR();
    if (!deadA) { finishSM(pA0, pA1, alA, l_reg, pa0, pa1, pa2, pa3); SBAR();
        pv_tile(vba, o, vb0, pa0, pa1, pa2, pa3); }
    if (even) { MASKT(pB0, pB1, NT - 1); deadB = partialSM(pB0, pB1, m_reg, mnB, alB); __syncthreads(); RESC(alB);
        if (!deadB) { finishSM(pB0, pB1, alB, l_reg, pa0, pa1, pa2, pa3); SBAR(); pv_tile(bt, o, vb0, pa0, pa1, pa2, pa3); } }
    SBAR(); SEAM_K0();
    if (hi == 0) li_l[r32] = l_reg; asm volatile("s_waitcnt lgkmcnt(0)" ::: "memory");
    int te = tid; asm volatile("" : "+v"(te));
    const int r32e = te & 31, hie = (te >> 5) & 1;
    float rli[16];
#pragma unroll
    for (int r = 0; r < 16; ++r) rli[r] = __builtin_amdgcn_rcpf(li_l[crow(r, hie)]);
    char* Ow = (char*)(cur.O + (size_t)(wid * QBLK) * OPITCH);
    const unsigned voff = (unsigned)((4 * hie * OPITCH + r32e) * 2);
#pragma unroll
    for (int r = 0; r < 16; ++r) { char* rb = Ow + (size_t)((r & 3) + 8 * (r >> 2)) * OPITCH * 2;
#pragma unroll
        for (int d0 = 0; d0 < 4; ++d0) { const float v = o[d0][r] * rli[r];
            const float vn = __shfl_xor(v, 1);
            if ((r32e & 1) == 0) *(unsigned*)(rb + d0 * 64 + voff) = cvtpk(v, vn); } }
    __syncthreads();
#undef RESC
#undef KBASE
#undef MASKT
#undef SEAM_K0
#undef HALF_STEP
}
#undef KVROW
#undef VMW
#undef VMWN
#undef SLOAD_H
#undef SWRITE_HK
#undef SWRITE_HV
#undef SWRITE_H
}
constexpr int NWAVES = 8, NTHREADS = 512, GRID = 256;
constexpr int BATCH = 4, SEQ = 8192, DM = 2048, DEPTH = 4, MROWS = BATCH * SEQ;
constexpr int MH = 4, DQK = 256, DV = 512, MLSTM_INW = 6152, NPROJ = 6144;
constexpr int FH = 16, FOX_INW = 6160;
constexpr int DFF = 5632, MODW = 6 * DM;
constexpr int LC = 256, NCH = SEQ / LC, NBH = BATCH * MH, NCHH = NBH * NCH;
constexpr float EPS = 1e-6f, SOFTCAP = 15.0f, SCALE_M = 0.0625f  , SCALE_A = 0.08838834764831845f  ;

constexpr size_t MiB = 1u << 20;
constexpr size_t WS_CTL = 0, CTL_ZERO_BYTES = 1 * MiB;
constexpr size_t WS_MOD = 1 * MiB;
constexpr size_t WS_WG = 3 * MiB;
constexpr size_t WS_WGF = WS_WG + 2 * 8 * 2048 * 4;
constexpr size_t WS_SCAN = 4 * MiB;
constexpr size_t WS_SA = WS_SCAN, WS_SM = WS_SA + 512 * 1024, WS_SF = WS_SM + 512 * 1024, WS_NB = WS_SF + 512 * 1024, WS_NST = WS_NB + 2 * MiB;
constexpr size_t WS_DNP = 10 * MiB;
constexpr size_t WS_GPRE = 8 * MiB;
constexpr size_t WS_WINM = 16 * MiB, WS_WINF = 64 * MiB, WS_WOUTM = 112 * MiB, WS_WOUTF = 128 * MiB, WS_WGU = 144 * MiB, WS_WDN = 320 * MiB;
constexpr size_t WS_H = 408 * MiB;
constexpr size_t WS_PROJ = 536 * MiB;
constexpr size_t WS_Y = 920 * MiB;
constexpr size_t WS_KWT = 1048 * MiB;
constexpr size_t WS_P = 1112 * MiB;
constexpr size_t WS_X = 1176 * MiB;
constexpr size_t WS_X2 = 1304 * MiB;
constexpr size_t WS_END = 1432 * MiB;
constexpr size_t OUT_CT2 = 128 * MiB;
constexpr int CW_KN = 256;
constexpr int CW_Q = 1024;
constexpr int CW_BAR = 4096;

constexpr int LDS_BYTES = 147456;
constexpr int MISC_OFF = LDS_BYTES - 1024;
constexpr int TR_SCR = 64 * 65 * 4;
static_assert(NWAVES * TR_SCR <= MISC_OFF && fa::LDS_BYTES <= MISC_OFF && pg8::STAGE_BYTES <= MISC_OFF, "LDS map");

#define GAS __attribute__((address_space(1)))
#define LAS __attribute__((address_space(3)))
typedef unsigned short bf16;
typedef unsigned v4u __attribute__((ext_vector_type(4)));
typedef unsigned v2u __attribute__((ext_vector_type(2)));
typedef float f32x4 __attribute__((ext_vector_type(4)));
typedef GAS unsigned gu32;
#define RLX_AGENT __ATOMIC_RELAXED, __HIP_MEMORY_SCOPE_AGENT
#define LDS_WAIT() asm volatile("s_waitcnt lgkmcnt(0)" ::: "memory")
#define VM_WAIT() asm volatile("s_waitcnt vmcnt(0)" ::: "memory")
__device__ __forceinline__ unsigned pk2(float lo, float hi) { unsigned r; asm volatile("v_cvt_pk_bf16_f32 %0, %1, %2" : "=v"(r) : "v"(lo), "v"(hi)); return r; }
__device__ __forceinline__ float bf_lo(unsigned w) { return __uint_as_float(w << 16); }
__device__ __forceinline__ float bf_hi(unsigned w) { return __uint_as_float(w & 0xffff0000u); }
__device__ __forceinline__ float h_lo(unsigned w) { return (float)__builtin_bit_cast(_Float16, (unsigned short)(w & 0xffffu)); }
__device__ __forceinline__ float h_hi(unsigned w) { return (float)__builtin_bit_cast(_Float16, (unsigned short)(w >> 16)); }
__device__ __forceinline__ unsigned pkh2(float lo, float hi) { const unsigned short a = __builtin_bit_cast(unsigned short, (_Float16)lo), b = __builtin_bit_cast(unsigned short, (_Float16)hi); return (unsigned)a | ((unsigned)b << 16); }
__device__ __forceinline__ f32x4 unpk_h4(v2u w) { const unsigned wx = w.x, wy = w.y; return (f32x4){h_lo(wx), h_hi(wx), h_lo(wy), h_hi(wy)}; }
__device__ __forceinline__ float wave_sum(float v) {
#pragma unroll
    for (int o = 1; o < 64; o <<= 1) v += __shfl_xor(v, o);
    return v;
}
__device__ __forceinline__ float sigmoidf_(float x) { return 1.0f / (1.0f + __expf(-x)); }
__device__ __forceinline__ float log1p01_(float e) { return e < 0.0078125f ? e * (1.0f + e * (-0.5f + e * (1.0f / 3.0f))) : __logf(1.0f + e); }
__device__ __forceinline__ float logsigmoidf_(float x) { return fminf(x, 0.f) - log1p01_(__expf(-fabsf(x))); }
__device__ __forceinline__ float tanhf_(float x) { const float e = __expf(-2.0f * fabsf(x)); const float t = (1.0f - e) / (1.0f + e); return x < 0.f ? -t : t; }

#define XB_TMO      128
#define XB_XCNT(j)  (256  + 64 * (j))
#define XB_XSUB(j)  (1280 + 64 * (j))
#define XB_XGEN(j)  (2304 + 64 * (j))
#define XB_TOP      3328
#define XB_TOPGEN   3392
#define XCD_BAR_WORDS 3456
#define XB_SPIN_CAP (1u << 18)
__device__ __forceinline__ unsigned xb_ld(unsigned* p)              { return __hip_atomic_load(p, __ATOMIC_RELAXED, __HIP_MEMORY_SCOPE_AGENT); }
__device__ __forceinline__ unsigned xb_add(unsigned* p, unsigned v) { return __hip_atomic_fetch_add(p, v, __ATOMIC_RELAXED, __HIP_MEMORY_SCOPE_AGENT); }
__device__ __forceinline__ unsigned xb_xcc_id() { return (unsigned)__builtin_amdgcn_s_getreg((3 << 11) | 20) & 0xFu; }
#define XB_SPIN(cond, bar) do { unsigned _sp = 0; while (cond) { __builtin_amdgcn_s_sleep(1); \
    if ((++_sp & 255u) == 0u) { if (xb_ld(&(bar)[XB_TMO])) break; if (_sp > XB_SPIN_CAP) { atomicAdd(&(bar)[XB_TMO], 1u); break; } } } } while (0)
struct XcdBarrier { unsigned* bar; unsigned x; volatile LAS unsigned* st; };
__device__ __forceinline__ XcdBarrier xcd_barrier_post(unsigned* bar, volatile LAS unsigned* st) {
    XcdBarrier b; b.bar = bar; b.x = xb_xcc_id(); b.st = st;
    if (threadIdx.x == 0) (void)xb_add(&bar[XB_XCNT(b.x)], 1u);
    return b;
}
__device__ __forceinline__ void xcd_barrier_complete(unsigned* bar, unsigned x, unsigned& nloc, unsigned& nx) {
    const unsigned G = gridDim.x * gridDim.y * gridDim.z;
    unsigned sum, cnt, mine, sp = 0u;
    for (;;) {
        sum = 0u; cnt = 0u; mine = 0u;
#pragma unroll
        for (unsigned j = 0; j < 16; ++j) { const unsigned c = xb_ld(&bar[XB_XCNT(j)]); sum += c; cnt += (c > 0u) ? 1u : 0u; mine = (j == x) ? c : mine; }
        if (sum == G) break;
        __builtin_amdgcn_s_sleep(1);
        if ((++sp & 255u) == 0u) { if (xb_ld(&bar[XB_TMO])) break; if (sp > XB_SPIN_CAP) { atomicAdd(&bar[XB_TMO], 1u); break; } }
    }
    nloc = mine > 0u ? mine : 1u; nx = cnt > 0u ? cnt : 1u;
}
__device__ __forceinline__ void xcd_barrier(const XcdBarrier& b) {
    asm volatile("s_waitcnt vmcnt(0)" ::: "memory");
    __syncthreads();
    if (threadIdx.x == 0) {
        unsigned* bar = b.bar;
        __builtin_amdgcn_s_waitcnt(0);
        unsigned nloc = b.st[0], nx = b.st[1];
        if (nloc == 0u) { xcd_barrier_complete(bar, b.x, nloc, nx); b.st[0] = nloc; b.st[1] = nx; }
        const unsigned old = xb_add(&bar[XB_XSUB(b.x)], 1u);
        const unsigned gen = old / nloc;
        if (old + 1u == (gen + 1u) * nloc) {
            __builtin_amdgcn_fence(__ATOMIC_RELEASE, "agent");
            asm volatile("s_waitcnt vmcnt(0)" ::: "memory");
            const unsigned og = xb_add(&bar[XB_TOP], 1u);
            const unsigned tg = og / nx;
            if (og + 1u == (tg + 1u) * nx) xb_add(&bar[XB_TOPGEN], 1u);
            else XB_SPIN(xb_ld(&bar[XB_TOPGEN]) == tg, bar);
            __builtin_amdgcn_fence(__ATOMIC_ACQUIRE, "agent");
            xb_add(&bar[XB_XGEN(b.x)], 1u);
            asm volatile("s_waitcnt vmcnt(0)" ::: "memory");
        } else {
            XB_SPIN(xb_ld(&bar[XB_XGEN(b.x)]) == gen, bar);
            __builtin_amdgcn_fence(__ATOMIC_ACQUIRE, "agent");
            asm volatile("s_waitcnt vmcnt(0)" ::: "memory");
        }
    }
    __syncthreads();
}

struct Args { const float* in[16]; float* out; unsigned char* ws; int ph_lo, ph_hi, li, pad; };
typedef const __attribute__((address_space(4))) Args* KArgP;
__device__ __forceinline__ KArgP kargs() { KArgP p = (KArgP)__builtin_amdgcn_kernarg_segment_ptr(); asm volatile("" : "+s"(p)); return p; }
struct Frame {
    LAS unsigned char* lds;
    int tid, lane, wave, bid, wave0;
    KArgP ka;
};
__device__ __forceinline__ void refresh(Frame& F) { F.ka = kargs();
    int t; asm volatile("v_mbcnt_lo_u32_b32 %0, -1, 0\n\tv_mbcnt_hi_u32_b32 %0, -1, %0" : "=v"(t));
    t += F.wave0 * 64; F.tid = t; { int b_ = (int)blockIdx.x; asm volatile("" : "+s"(b_)); F.bid = b_; } F.lane = t & 63; F.wave = __builtin_amdgcn_readfirstlane(t >> 6); }

__device__ __forceinline__ void tr_out(LAS float* scr, bf16* dst  , size_t ldt, int lane) {
    const int nl = lane & 7, c = lane >> 3;
#pragma unroll
    for (int j = 0; j < 8; ++j) { const int n = nl + 8 * j; const LAS float* s = scr + (8 * c) * 65 + n;
        v4u o; o.x = pk2(s[0], s[65]); o.y = pk2(s[130], s[195]); o.z = pk2(s[260], s[325]); o.w = pk2(s[390], s[455]);
        *(GAS v4u*)(dst + (size_t)n * ldt + 8 * c) = o; }
    LDS_WAIT();
}
__device__ __forceinline__ void tr_load_f32(f32x4 (&v)[16], const float* src  , size_t lds_, int lane) {
    const int cq = lane & 15, rq = lane >> 4;
#pragma unroll
    for (int i = 0; i < 16; ++i) v[i] = *(const GAS f32x4*)(src + (size_t)(rq + 4 * i) * lds_ + 4 * cq);
}
__device__ __forceinline__ void tr_stage_f32(const f32x4 (&v)[16], bf16* dst, size_t ldt, LAS float* scr, int lane) {
    const int cq = lane & 15, rq = lane >> 4;
#pragma unroll
    for (int i = 0; i < 16; ++i) { LAS float* d = scr + (rq + 4 * i) * 65 + 4 * cq; d[0] = v[i].x; d[1] = v[i].y; d[2] = v[i].z; d[3] = v[i].w; }
    LDS_WAIT();
    tr_out(scr, dst, ldt, lane);
}

__device__ __forceinline__ void p0_prologue(Frame& F) {
    const int tid = F.tid, lane = F.lane, wave = F.wave;
    {
        const int u = F.bid;
        if (u < 256) {
            const int l = u >> 6, cg = u & 63;
            f32x4 acc[4];
#pragma unroll
            for (int b = 0; b < 4; ++b) acc[b] = (f32x4){0.f, 0.f, 0.f, 0.f};
            if (lane < 48) {
                const float* W = F.ka->in[2] + (size_t)l * DM * MODW + cg * 192 + 4 * lane;
                const int kb = wave * 256;
                for (int kk = 0; kk < 256; kk += 8) {
                    f32x4 w[8];
#pragma unroll
                    for (int j = 0; j < 8; ++j) w[j] = *(const GAS f32x4*)(W + (size_t)(kb + kk + j) * MODW);
#pragma unroll
                    for (int j = 0; j < 8; ++j) {
#pragma unroll
                        for (int b = 0; b < 4; ++b) { const float cv = F.ka->in[1][b * DM + kb + kk + j]; const float s = cv * sigmoidf_(cv); acc[b] += w[j] * s; } }
                }
            }
            LAS float* red = (LAS float*)F.lds;
            if (lane < 48) {
#pragma unroll
                for (int b = 0; b < 4; ++b) *(LAS f32x4*)(red + (wave * 4 + b) * 192 + 4 * lane) = acc[b]; }
            __syncthreads();
            for (int o = tid; o < 768; o += NTHREADS) { const int b = o / 192, col = o % 192; float s = 0.f;
#pragma unroll
                for (int w = 0; w < 8; ++w) s += red[(w * 4 + b) * 192 + col];
                const int j = cg * 192 + col;
                ((float*)(F.ka->ws + WS_MOD))[(size_t)(l * 4 + b) * MODW + j] = s + F.ka->in[3][(size_t)l * MODW + j]; }
            __syncthreads();
        }
    }
    {
        const int gt = F.bid * NTHREADS + tid;
        if (gt < 2 * 8 * 2048) { const int j = gt / (8 * 2048), r = gt % (8 * 2048), g = r / 2048, k = r % 2048;
            ((float*)(F.ka->ws + WS_WG))[gt] = F.ka->in[6][((size_t)j * DM + k) * MLSTM_INW + NPROJ + g]; }
        else if (gt < 2 * 8 * 2048 + 2 * 16 * 2048) { const int q = gt - 2 * 8 * 2048; const int j = q / (16 * 2048), r = q % (16 * 2048), g = r / 2048, k = r % 2048;
            ((float*)(F.ka->ws + WS_WGF))[q] = F.ka->in[10][((size_t)j * DM + k) * FOX_INW + NPROJ + g]; }
    }
    {
        LAS float* scr = (LAS float*)(F.lds + wave * TR_SCR);
        const int gw = F.bid * NWAVES + wave, NGW = GRID * NWAVES;
        constexpr int I_IN = 32 * 96, I_OUT = 32 * 32, I_GU = 32 * 176, I_DN = 88 * 32;
        constexpr int E0 = 2 * I_IN, E1 = E0 + 2 * I_IN, E2 = E1 + 2 * I_OUT, E3 = E2 + 2 * I_OUT, E4 = E3 + 4 * I_GU, E5 = E4 + 4 * I_DN;
#define P0_DECODE(it_, src_, lds_, dst_, ldt_) do { \
            if ((it_) < E0) { const int j = (it_) / I_IN, r = (it_) % I_IN, kb = r / 96, nb = r % 96; \
                src_ = F.ka->in[6] + ((size_t)j * DM + kb * 64) * MLSTM_INW + nb * 64; lds_ = MLSTM_INW; dst_ = (bf16*)(F.ka->ws + WS_WINM) + ((size_t)j * NPROJ + nb * 64) * DM + kb * 64; ldt_ = DM; } \
            else if ((it_) < E1) { const int q = (it_) - E0, j = q / I_IN, r = q % I_IN, kb = r / 96, nb = r % 96; \
                src_ = F.ka->in[10] + ((size_t)j * DM + kb * 64) * FOX_INW + nb * 64; lds_ = FOX_INW; dst_ = (bf16*)(F.ka->ws + WS_WINF) + ((size_t)j * NPROJ + nb * 64) * DM + kb * 64; ldt_ = DM; } \
            else if ((it_) < E2) { const int q = (it_) - E1, j = q / I_OUT, r = q % I_OUT, kb = r / 32, nb = r % 32; \
                src_ = F.ka->in[9] + ((size_t)j * DM + kb * 64) * DM + nb * 64; lds_ = DM; dst_ = (bf16*)(F.ka->ws + WS_WOUTM) + ((size_t)j * DM + nb * 64) * DM + kb * 64; ldt_ = DM; } \
            else if ((it_) < E3) { const int q = (it_) - E2, j = q / I_OUT, r = q % I_OUT, kb = r / 32, nb = r % 32; \
                src_ = F.ka->in[12] + ((size_t)j * DM + kb * 64) * DM + nb * 64; lds_ = DM; dst_ = (bf16*)(F.ka->ws + WS_WOUTF) + ((size_t)j * DM + nb * 64) * DM + kb * 64; ldt_ = DM; } \
            else if ((it_) < E4) { const int q = (it_) - E3, j = q / I_GU, r = q % I_GU, kb = r / 176, nb = r % 176; \
                const int n0 = nb * 64, jj = n0 < DFF ? n0 : n0 - DFF, drow = (jj >> 7) * 256 + (n0 < DFF ? 0 : 128) + (jj & 127); \
                src_ = F.ka->in[13] + ((size_t)j * DM + kb * 64) * (2 * DFF) + n0; lds_ = 2 * DFF; dst_ = (bf16*)(F.ka->ws + WS_WGU) + ((size_t)j * 2 * DFF + drow) * DM + kb * 64; ldt_ = DM; } \
            else { const int q = (it_) - E4, j = q / I_DN, r = q % I_DN, kb = r / 32, nb = r % 32; \
                src_ = F.ka->in[14] + ((size_t)j * DFF + kb * 64) * DM + nb * 64; lds_ = DM; dst_ = (bf16*)(F.ka->ws + WS_WDN) + ((size_t)j * DM + nb * 64) * DFF + kb * 64; ldt_ = DFF; } } while (0)
        for (int it = gw; it < E5; it += 2 * NGW) {
            const int it2 = it + NGW; const bool two = it2 < E5;
            const float *srcA, *srcB = nullptr; bf16 *dstA, *dstB = nullptr; size_t lsA, lsB = 0, ltA, ltB = 0;
            P0_DECODE(it, srcA, lsA, dstA, ltA);
            if (two) P0_DECODE(it2, srcB, lsB, dstB, ltB);
            f32x4 va[16], vb[16];
            tr_load_f32(va, srcA, lsA, lane);
            if (two) tr_load_f32(vb, srcB, lsB, lane);
            tr_stage_f32(va, dstA, ltA, scr, lane);
            if (two) tr_stage_f32(vb, dstB, ltB, scr, lane);
        }
#undef P0_DECODE
    }
}

template <bool XF> struct XRaw { typedef v2u type; };
template <> struct XRaw<true> { typedef f32x4 type; };
__device__ __forceinline__ f32x4 np_cvt(f32x4 w) { return w; }
__device__ __forceinline__ f32x4 np_cvt(v2u w) { return unpk_h4(w); }
template <int NG, bool XF>
__device__ __forceinline__ void norm_phase(Frame& F, const void* xsrc_, const float* nw, const float* mod_l, int sh_off, int sc_off, const float* Wg) {
    const float* xsrc = (const float*)xsrc_; const unsigned short* xh = (const unsigned short*)xsrc_;
    constexpr bool PREG = !XF;
    constexpr int NR = XF ? 8 : 4;
#define NP_EOFF(j_) (512 * ((j_) >> 1) + 4 * ((j_) & 1))
#define NP_LDR(dst_, r_) do { _Pragma("unroll") for (int q_ = 0; q_ < NR; ++q_) { \
        if constexpr (XF) dst_[q_] = __builtin_bit_cast(v4u, *(const GAS f32x4*)(xsrc + (size_t)(r_) * DM + NP_EOFF(q_) + 8 * lane)); \
        else dst_[q_] = *(const GAS v4u*)(xh + (size_t)(r_) * DM + 512 * q_ + 8 * lane); } } while (0)
#define NP_CVT(y_, src_) do { _Pragma("unroll") for (int q_ = 0; q_ < NR; ++q_) { \
        if constexpr (XF) y_[q_] = __builtin_bit_cast(f32x4, src_[q_]); \
        else { const v4u w_ = src_[q_]; y_[2 * q_] = (f32x4){h_lo(w_.x), h_hi(w_.x), h_lo(w_.y), h_hi(w_.y)}; y_[2 * q_ + 1] = (f32x4){h_lo(w_.z), h_hi(w_.z), h_lo(w_.w), h_hi(w_.w)}; } } } while (0)
    const int tid = F.tid, lane = F.lane, wave = F.wave;
    if constexpr (NG > 0) {
        for (int i = tid; i < NG * 512; i += NTHREADS) { const int g = i >> 9, d = i & 511, j = d >> 6, ln = d & 63;
            ((LAS f32x4*)F.lds)[i] = ((const GAS f32x4*)Wg)[g * 512 + 128 * (j >> 1) + 2 * ln + (j & 1)]; }
        __syncthreads();
    }
    bf16* H = (bf16*)(F.ka->ws + WS_H); float* gpre = (float*)(F.ka->ws + WS_GPRE);
    const int gw = F.bid * NWAVES + wave, rows_per = MROWS / (GRID * NWAVES);
    const int row0 = gw * rows_per, b = row0 / SEQ;
    const float* scp = mod_l + (size_t)b * MODW + sc_off + 8 * lane; const float* shp = mod_l + (size_t)b * MODW + sh_off + 8 * lane; const float* nwp = nw + 8 * lane;
    f32x4 y0[8], y1[8];
    { v4u f0[NR], f1[NR]; NP_LDR(f0, row0); NP_LDR(f1, row0 + 1); NP_CVT(y0, f0); NP_CVT(y1, f1); }
    f32x4 pav[PREG ? 8 : 1], shv[PREG ? 8 : 1];
    if constexpr (PREG) {
#pragma unroll
        for (int j = 0; j < 8; ++j) { const f32x4 w = *(const GAS f32x4*)(nwp + NP_EOFF(j)), sc = *(const GAS f32x4*)(scp + NP_EOFF(j)); pav[j] = w * (sc + 1.0f); shv[j] = *(const GAS f32x4*)(shp + NP_EOFF(j)); } }
    for (int rp = 0; rp < rows_per; rp += 2) {
        const int r0 = row0 + rp;
        if constexpr (!PREG) asm volatile("" : "+v"(scp), "+v"(shp), "+v"(nwp));
        const int rn = (rp + 2 < rows_per) ? r0 + 2 : r0;
        v4u n0[NR], n1[NR];
        NP_LDR(n0, rn); NP_LDR(n1, rn + 1);
        float s0 = 0.f, s1 = 0.f;
#pragma unroll
        for (int j = 0; j < 8; ++j) { s0 += (y0[j].x * y0[j].x + y0[j].y * y0[j].y) + (y0[j].z * y0[j].z + y0[j].w * y0[j].w); s1 += (y1[j].x * y1[j].x + y1[j].y * y1[j].y) + (y1[j].z * y1[j].z + y1[j].w * y1[j].w); }
        s0 = wave_sum(s0); s1 = wave_sum(s1);
        const float rs0 = rsqrtf(s0 * (1.0f / DM) + EPS), rs1 = rsqrtf(s1 * (1.0f / DM) + EPS);
#pragma unroll
        for (int c = 0; c < 4; ++c) {
#pragma unroll
            for (int hh = 0; hh < 2; ++hh) { const int j = 2 * c + hh; f32x4 pa, sh;
                if constexpr (PREG) { pa = pav[j]; sh = shv[j]; }
                else { const f32x4 w = *(const GAS f32x4*)(nwp + NP_EOFF(j)), sc = *(const GAS f32x4*)(scp + NP_EOFF(j)); sh = *(const GAS f32x4*)(shp + NP_EOFF(j)); pa = w * (sc + 1.0f); }
                y0[j] = y0[j] * rs0 * pa + sh; y1[j] = y1[j] * rs1 * pa + sh; }
            v4u o0, o1; o0.x = pk2(y0[2 * c].x, y0[2 * c].y); o0.y = pk2(y0[2 * c].z, y0[2 * c].w); o0.z = pk2(y0[2 * c + 1].x, y0[2 * c + 1].y); o0.w = pk2(y0[2 * c + 1].z, y0[2 * c + 1].w);
            o1.x = pk2(y1[2 * c].x, y1[2 * c].y); o1.y = pk2(y1[2 * c].z, y1[2 * c].w); o1.z = pk2(y1[2 * c + 1].x, y1[2 * c + 1].y); o1.w = pk2(y1[2 * c + 1].z, y1[2 * c + 1].w);
            *(GAS v4u*)(H + (size_t)r0 * DM + 512 * c + 8 * lane) = o0; *(GAS v4u*)(H + (size_t)(r0 + 1) * DM + 512 * c + 8 * lane) = o1; }
        if constexpr (NG > 0) {
#pragma unroll 1
            for (int g0 = 0; g0 < NG; g0 += 2) {
                const LAS float* wl = (const LAS float*)F.lds + g0 * DM + 4 * lane;
                float t00 = 0.f, t01 = 0.f, t10 = 0.f, t11 = 0.f;
#pragma unroll
                for (int j = 0; j < 8; ++j) { const f32x4 wa = *(const LAS f32x4*)(wl + 256 * j), wb = *(const LAS f32x4*)(wl + DM + 256 * j);
                    t00 += (y0[j].x * wa.x + y0[j].y * wa.y) + (y0[j].z * wa.z + y0[j].w * wa.w); t01 += (y0[j].x * wb.x + y0[j].y * wb.y) + (y0[j].z * wb.z + y0[j].w * wb.w);
                    t10 += (y1[j].x * wa.x + y1[j].y * wa.y) + (y1[j].z * wa.z + y1[j].w * wa.w); t11 += (y1[j].x * wb.x + y1[j].y * wb.y) + (y1[j].z * wb.z + y1[j].w * wb.w); }
                t00 = wave_sum(t00); t01 = wave_sum(t01); t10 = wave_sum(t10); t11 = wave_sum(t11);
                if (lane == 0) { typedef float f32x2_t __attribute__((ext_vector_type(2)));
                    *(GAS f32x2_t*)(gpre + (size_t)g0 * MROWS + r0) = (f32x2_t){t00, t10}; *(GAS f32x2_t*)(gpre + (size_t)(g0 + 1) * MROWS + r0) = (f32x2_t){t01, t11}; }
            }
        }
        NP_CVT(y0, n0); NP_CVT(y1, n1);
    }
    if constexpr (NG > 0) __syncthreads();
#undef NP_EOFF
#undef NP_LDR
#undef NP_CVT
}

__device__ __forceinline__ float block_excl_sum(Frame& F, float tot, LAS float* scr) {
    float inc = tot;
#pragma unroll
    for (int o = 1; o < 64; o <<= 1) { const float t = __shfl_up(inc, o); if (F.lane >= o) inc += t; }
    if (F.lane == 63) scr[F.wave] = inc;
    __syncthreads();
    float base = 0.f;
    for (int w = 0; w < F.wave; ++w) base += scr[w];
    __syncthreads();
    return base + inc - tot;
}
__device__ __forceinline__ float block_excl_max(Frame& F, float tot, LAS float* scr) {
    float inc = tot;
#pragma unroll
    for (int o = 1; o < 64; o <<= 1) { const float t = __shfl_up(inc, o); if (F.lane >= o) inc = fmaxf(inc, t); }
    if (F.lane == 63) scr[F.wave] = inc;
    __syncthreads();
    float base = -__builtin_inff();
    for (int w = 0; w < F.wave; ++w) base = fmaxf(base, scr[w]);
    __syncthreads();
    const float prev = __shfl_up(inc, 1);
    return fmaxf(base, F.lane > 0 ? prev : -__builtin_inff());
}
__device__ __forceinline__ void mlstm_gate_scan(Frame& F, int bh, const float* bgates  ) {
    const int b = bh >> 2, h = bh & 3, t0 = F.tid * 16;
    const float* gpi = (const float*)(F.ka->ws + WS_GPRE) + (size_t)h * MROWS + (size_t)b * SEQ + t0;
    const float* gpf = gpi + (size_t)4 * MROWS;
    LAS float* scr = (LAS float*)F.lds;
    const float bi = bgates[h], bf = bgates[4 + h];
    float gI[16], gF[16];
#pragma unroll
    for (int q = 0; q < 4; ++q) { const f32x4 a = *(const GAS f32x4*)(gpi + 4 * q), c = *(const GAS f32x4*)(gpf + 4 * q);
        gI[4 * q] = a.x; gI[4 * q + 1] = a.y; gI[4 * q + 2] = a.z; gI[4 * q + 3] = a.w; gF[4 * q] = c.x; gF[4 * q + 1] = c.y; gF[4 * q + 2] = c.z; gF[4 * q + 3] = c.w; }
    float li[16], fc[16];
    float run = 0.f;
#pragma unroll
    for (int i = 0; i < 16; ++i) { const float gi = gI[i] + bi, gf = gF[i] + bf;
        li[i] = SOFTCAP * tanhf_(gi * (1.0f / SOFTCAP)); const float lf = logsigmoidf_(SOFTCAP * tanhf_(gf * (1.0f / SOFTCAP))); run += lf; fc[i] = run; }
    const float basef = block_excl_sum(F, run, scr);
    float am = -__builtin_inff(); float av[16];
#pragma unroll
    for (int i = 0; i < 16; ++i) { fc[i] += basef; av[i] = li[i] - fc[i]; am = fmaxf(am, av[i]); }
    float m = fmaxf(block_excl_max(F, am, scr), 0.f);
    float* SA = (float*)(F.ka->ws + WS_SA) + (size_t)bh * SEQ + t0; float* SM = (float*)(F.ka->ws + WS_SM) + (size_t)bh * SEQ + t0; float* SF = (float*)(F.ka->ws + WS_SF) + (size_t)bh * SEQ + t0;
#pragma unroll
    for (int i = 0; i < 16; ++i) { m = fmaxf(m, av[i]); SA[i] = av[i]; SM[i] = m; SF[i] = fc[i]; }
}
__device__ __forceinline__ void fox_gate_scan(Frame& F, int bh, const float* bfv  ) {
    const int b = bh >> 4, h = bh & 15, t0 = F.tid * 16;
    const float* gp = (const float*)(F.ka->ws + WS_GPRE) + (size_t)h * MROWS + (size_t)b * SEQ + t0;
    LAS float* scr = (LAS float*)F.lds;
    const float bb = bfv[h];
    float gv[16];
#pragma unroll
    for (int q = 0; q < 4; ++q) { const f32x4 a = *(const GAS f32x4*)(gp + 4 * q); gv[4 * q] = a.x; gv[4 * q + 1] = a.y; gv[4 * q + 2] = a.z; gv[4 * q + 3] = a.w; }
    float fc[16]; float run = 0.f;
#pragma unroll
    for (int i = 0; i < 16; ++i) { run += logsigmoidf_(gv[i] + bb); fc[i] = run; }
    const float basef = block_excl_sum(F, run, scr);
    float* NB = (float*)(F.ka->ws + WS_NB) + (size_t)bh * SEQ + t0;
#pragma unroll
    for (int i = 0; i < 16; ++i) NB[i] = -(fc[i] + basef) * (1.0f / SCALE_A);
}

struct MainSched {
    pg8::TileOrder T; const char* A; const char* B; char* O; size_t tA, tB, tOm, tOn;
    __device__ __forceinline__ bool next(int i, pg8::Unit& u) const { int pm, pn; if (!T.tile(i, pm, pn)) return false;
        u.pm = pm; u.pn = pn; u.A = A + (size_t)pm * tA; u.B = B + (size_t)pn * tB; u.A1 = nullptr; u.B1 = nullptr; u.O = O + (size_t)pm * tOm + (size_t)pn * tOn; return true; }
};
struct EpiStore {
    static constexpr bool PERM = true; int ldo; unsigned* kn;
    __device__ __forceinline__ void operator()(const pg8::f32x4 (&acc)[2][2][4][2], const pg8::Unit& u, int wr, int wc, int fr, int fq, PG8_LAS unsigned char* scr) const {
        if (kn != nullptr && u.pn >= 8 && u.pn < 16) {
            float km0 = 0.f, km1 = 0.f;
#pragma unroll
            for (int ai = 0; ai < 2; ++ai)
#pragma unroll
                for (int m = 0; m < 4; ++m) {
                    float s0 = 0.f, s1 = 0.f;
#pragma unroll
                    for (int n = 0; n < 2; ++n)
#pragma unroll
                        for (int e = 0; e < 4; ++e) { s0 = fmaf(acc[ai][0][m][n][e], acc[ai][0][m][n][e], s0); s1 = fmaf(acc[ai][1][m][n][e], acc[ai][1][m][n][e], s1); }
                    s0 += __shfl_xor(s0, 16); s1 += __shfl_xor(s1, 16); s0 += __shfl_xor(s0, 32); s1 += __shfl_xor(s1, 32);
                    km0 = fmaxf(km0, s0); km1 = fmaxf(km1, s1); }
#pragma unroll
            for (int o = 1; o < 16; o <<= 1) { km0 = fmaxf(km0, __shfl_xor(km0, o)); km1 = fmaxf(km1, __shfl_xor(km1, o)); }
            if (fq == 0 && fr == 0) { unsigned* kp = kn + (((u.pm >> 5) * 16 + 2 * (u.pn - 8)) * 4 + wc);
                atomicMax(kp, __float_as_uint(km0)); atomicMax(kp + 4, __float_as_uint(km1)); }
        }
        const int lane = fq * 16 + fr, rr = lane >> 2, ch = lane & 3;
        bf16* base = (bf16*)u.O + (size_t)(wr * 64 + rr) * ldo + wc * 32 + 8 * ch;
        PG8_LAS unsigned char* wp = scr + fr * 64 + ((fq ^ ((fr >> 1) & 3)) * 16);
        PG8_LAS unsigned char* rp = scr + rr * 64 + ((ch ^ ((rr >> 1) & 3)) * 16);
#pragma unroll
        for (int ai = 0; ai < 2; ++ai)
#pragma unroll
            for (int m = 0; m < 4; ++m) { bf16* rowp = base + (size_t)(ai * 128 + m * 16) * ldo;
#pragma unroll
                for (int bj = 0; bj < 2; ++bj) { const pg8::f32x4 v0 = acc[ai][bj][m][0], v1 = acc[ai][bj][m][1];
                    v4u w; w.x = pk2(v0[0], v0[1]); w.y = pk2(v0[2], v0[3]); w.z = pk2(v1[0], v1[1]); w.w = pk2(v1[2], v1[3]);
                    *(PG8_LAS v4u*)(wp + bj * 8192) = w;
                    const v4u t = *(const PG8_LAS v4u*)(rp + bj * 8192);
                    *(GAS v4u*)(rowp + bj * 128) = t; } }
    }
};
struct EpiSwiglu {
    static constexpr bool PERM = true;
    __device__ __forceinline__ void operator()(const pg8::f32x4 (&acc)[2][2][4][2], const pg8::Unit& u, int wr, int wc, int fr, int fq, PG8_LAS unsigned char* scr) const {
        const int lane = fq * 16 + fr, rr = lane >> 2, ch = lane & 3;
        bf16* base = (bf16*)u.O + (size_t)(wr * 64 + rr) * DFF + wc * 32 + 8 * ch;
        PG8_LAS unsigned char* wp = scr + fr * 64 + ((fq ^ ((fr >> 1) & 3)) * 16);
        PG8_LAS unsigned char* rp = scr + rr * 64 + ((ch ^ ((rr >> 1) & 3)) * 16);
#pragma unroll
        for (int ai = 0; ai < 2; ++ai)
#pragma unroll
            for (int m = 0; m < 4; ++m) { float r[8];
#pragma unroll
                for (int n = 0; n < 2; ++n)
#pragma unroll
                    for (int e = 0; e < 4; ++e) { const float g = acc[ai][0][m][n][e], up = acc[ai][1][m][n][e]; r[4 * n + e] = g * up * __builtin_amdgcn_rcpf(1.0f + __expf(-g)); }
                v4u w; w.x = pk2(r[0], r[1]); w.y = pk2(r[2], r[3]); w.z = pk2(r[4], r[5]); w.w = pk2(r[6], r[7]);
                *(PG8_LAS v4u*)(wp + (m & 1) * 8192) = w;
                const v4u t = *(const PG8_LAS v4u*)(rp + (m & 1) * 8192);
                *(GAS v4u*)(base + (size_t)(ai * 128 + m * 16) * DFF) = t; }
    }
};
template <bool XF, int AH = 2>
struct EpiResid {
    static constexpr bool PERM = false; const float* gate_l  ; const void* xin  ;
    static constexpr int AHEAD = XF ? 2 : AH, NB = (AHEAD == 8) ? 8 : 3;
    __device__ __forceinline__ void operator()(const pg8::f32x4 (&acc)[2][2][4][2], const pg8::Unit& u, int wr, int wc, int fr, int fq, PG8_LAS unsigned char* scr) const {
        const int b = u.pm >> 5;
        const int lane = fq * 16 + fr, rr = lane >> 2, c2 = lane & 3;
        const float* gp = gate_l + (size_t)b * MODW + u.pn * 256 + wc * 32 + 8 * c2;
        pg8::f32x4 gv[2][2];
#pragma unroll
        for (int bj = 0; bj < 2; ++bj) { gv[bj][0] = *(const GAS pg8::f32x4*)(gp + bj * 128); gv[bj][1] = *(const GAS pg8::f32x4*)(gp + bj * 128 + 4); }
        unsigned short* obase = (unsigned short*)u.O + (size_t)(wr * 64 + rr) * DM + wc * 32 + 8 * c2;
        const size_t eoff = (size_t)(u.pm * 256 + wr * 64 + rr) * DM + u.pn * 256 + wc * 32 + 8 * c2;
        PG8_LAS unsigned char* wp0 = scr + (fr >> 3) * 8192 + (fr & 7) * 128;
        const int wx0 = ((fq) ^ (fr & 7)) * 16, wx1 = ((4 + fq) ^ (fr & 7)) * 16;
        PG8_LAS unsigned char* rp0 = scr + (rr >> 3) * 8192 + (rr & 7) * 128;
        const int rx0 = ((2 * c2) ^ (rr & 7)) * 16, rx1 = ((2 * c2 + 1) ^ (rr & 7)) * 16;
        v4u xh[XF ? 1 : NB][2]; pg8::f32x4 xf[XF ? NB : 1][4];
#define ER_LOAD(g_) do { const size_t q_ = eoff + (size_t)(((g_) >> 2) * 128 + ((g_) & 3) * 16) * DM; \
            if constexpr (XF) { const float* f_ = (const float*)xin + q_; xf[(g_) % NB][0] = *(const GAS pg8::f32x4*)f_; xf[(g_) % NB][1] = *(const GAS pg8::f32x4*)(f_ + 4); \
                xf[(g_) % NB][2] = *(const GAS pg8::f32x4*)(f_ + 128); xf[(g_) % NB][3] = *(const GAS pg8::f32x4*)(f_ + 132); } \
            else { const unsigned short* h_ = (const unsigned short*)xin + q_; xh[(g_) % NB][0] = *(const GAS v4u*)h_; xh[(g_) % NB][1] = *(const GAS v4u*)(h_ + 128); } } while (0)
#pragma unroll
        for (int g = 0; g < AHEAD; ++g) ER_LOAD(g);
#pragma unroll
        for (int g = 0; g < 8; ++g) { const int ai = g >> 2, m = g & 3; unsigned short* p = obase + (size_t)(ai * 128 + m * 16) * DM;
            if (g + AHEAD < 8) ER_LOAD(g + AHEAD);
#pragma unroll
            for (int bj = 0; bj < 2; ++bj) {
                *(PG8_LAS pg8::f32x4*)(wp0 + wx0) = acc[ai][bj][m][0]; *(PG8_LAS pg8::f32x4*)(wp0 + wx1) = acc[ai][bj][m][1];
                const pg8::f32x4 va = *(const PG8_LAS pg8::f32x4*)(rp0 + rx0), vb = *(const PG8_LAS pg8::f32x4*)(rp0 + rx1);
                pg8::f32x4 xa, xb;
                if constexpr (XF) { xa = xf[g % NB][2 * bj]; xb = xf[g % NB][2 * bj + 1]; }
                else { const v4u w = xh[g % NB][bj]; xa = (pg8::f32x4){h_lo(w.x), h_hi(w.x), h_lo(w.y), h_hi(w.y)}; xb = (pg8::f32x4){h_lo(w.z), h_hi(w.z), h_lo(w.w), h_hi(w.w)}; }
                const pg8::f32x4 ra = xa + gv[bj][0] * va, rb = xb + gv[bj][1] * vb;
                v4u o; o.x = pkh2(ra[0], ra[1]); o.y = pkh2(ra[2], ra[3]); o.z = pkh2(rb[0], rb[1]); o.w = pkh2(rb[2], rb[3]);
                *(GAS v4u*)(p + bj * 128) = o;
            } }
#undef ER_LOAD
    }
};
struct SchedS {
    int G, c; const char* proj; char* P;
    __device__ __forceinline__ bool next(int i, pg8::Unit& u) const { const int L0 = i * G + c; if (L0 >= NCHH) return false;
        const int L = (L0 & 7) * (NCHH / 8) + (L0 >> 3);
        const int bh = L >> 5, cc = L & 31, b = bh >> 2, h = bh & 3; const size_t row0 = (size_t)b * SEQ + cc * LC;
        u.pm = L; u.pn = 0; u.A = proj + (row0 * NPROJ + h * DQK) * 2; u.B = proj + (row0 * NPROJ + 1024 + h * DQK) * 2; u.A1 = nullptr; u.B1 = nullptr; u.O = P + (size_t)L * LC * LC * 2; return true; }
};
struct EpiS {
    static constexpr bool PERM = true; const float* SA; const float* SM;
    __device__ __forceinline__ void operator()(const pg8::f32x4 (&acc)[2][2][4][2], const pg8::Unit& u, int wr, int wc, int fr, int fq, PG8_LAS unsigned char* scr) const {
        const float* sa = SA + (size_t)u.pm * LC; const float* sm = SM + (size_t)u.pm * LC;
        bf16* base = (bf16*)u.O + (size_t)(wr * 64 + fr) * LC + wc * 32 + 8 * fq;
        pg8::f32x4 av[2][2];
#pragma unroll
        for (int bj = 0; bj < 2; ++bj)
#pragma unroll
            for (int n = 0; n < 2; ++n) av[bj][n] = *(const GAS pg8::f32x4*)(sa + bj * 128 + wc * 32 + 8 * fq + 4 * n);
#pragma unroll
        for (int ai = 0; ai < 2; ++ai)
#pragma unroll
            for (int m = 0; m < 4; ++m) { const int t = ai * 128 + wr * 64 + m * 16 + fr; const float mt = sm[t];
#pragma unroll
                for (int bj = 0; bj < 2; ++bj) { float r[8];
#pragma unroll
                    for (int n = 0; n < 2; ++n)
#pragma unroll
                        for (int e = 0; e < 4; ++e) { const int s = bj * 128 + wc * 32 + 8 * fq + 4 * n + e;
                            r[4 * n + e] = (s <= t) ? SCALE_M * acc[ai][bj][m][n][e] * __expf(av[bj][n][e] - mt) : 0.f; }
                    v4u w; w.x = pk2(r[0], r[1]); w.y = pk2(r[2], r[3]); w.z = pk2(r[4], r[5]); w.w = pk2(r[6], r[7]);
                    *(GAS v4u*)(base + (size_t)(ai * 128 + m * 16) * LC + bj * 128) = w; } }
    }
};
struct SchedDC {
    int G, c; const char* VT; const char* KWT; char* CT;
    __device__ __forceinline__ bool next(int i, pg8::Unit& u) const { const int L0 = i * G + c; if (L0 >= 2 * NCHH) return false;
        const int L = (L0 & 7) * (2 * NCHH / 8) + (L0 >> 3);
        const int ch = L >> 1, half = L & 1;
        u.pm = ch; u.pn = half; u.A = VT + ((size_t)ch * DV + half * 256) * LC * 2; u.B = KWT + (size_t)ch * DQK * LC * 2; u.A1 = nullptr; u.B1 = nullptr; u.O = CT + ((size_t)ch * DV + half * 256) * DQK * 2; return true; }
};
struct SchedNum {
    int G, c; const char* proj; const char* CT; const char* P; const char* VT; char* Y;
    __device__ __forceinline__ bool next(int i, pg8::Unit& u) const { const int L0 = i * G + c; if (L0 >= 2 * NCHH) return false;
        const int L = (L0 & 7) * (2 * NCHH / 8) + (L0 >> 3);
        const int ch = L >> 1, half = L & 1, bh = ch >> 5, cc = ch & 31, b = bh >> 2, h = bh & 3; const size_t row0 = (size_t)b * SEQ + cc * LC;
        u.pm = ch; u.pn = half; u.A = proj + (row0 * NPROJ + h * DQK) * 2; u.B = CT + ((size_t)ch * DV + half * 256) * DQK * 2;
        u.A1 = P + (size_t)ch * LC * LC * 2; u.B1 = VT + ((size_t)ch * DV + half * 256) * LC * 2; u.O = Y + (row0 * DM + h * DV + half * 256) * 2; return true; }
};
struct EpiNum : EpiStore {
    const float* SM;
    __device__ __forceinline__ void mid(pg8::f32x4 (&acc)[2][2][4][2], const pg8::Unit& u, int wr, int wc, int fr, int fq, PG8_LAS unsigned char* scr) const {
        const float* sm = SM + (size_t)u.pm * LC; const float mc = (u.pm & 31) ? sm[-1] : 0.f;
#pragma unroll
        for (int ai = 0; ai < 2; ++ai)
#pragma unroll
            for (int m = 0; m < 4; ++m) { const float r = SCALE_M * __expf(mc - sm[ai * 128 + wr * 64 + m * 16 + fr]);
#pragma unroll
                for (int bj = 0; bj < 2; ++bj)
#pragma unroll
                    for (int n = 0; n < 2; ++n) acc[ai][bj][m][n] *= r; }
    }
};

#define MP_DECODE(it_, ch_, isK_, sb_, db_, src_, dst_) do { ch_ = (it_) / 48; const int r_ = (it_) % 48, bh_ = ch_ >> 5, cc_ = ch_ & 31, b_ = bh_ >> 2, h_ = bh_ & 3; \
        const size_t row0_ = (size_t)b_ * SEQ + cc_ * LC; isK_ = r_ < 16; int colbase_; \
        if (isK_) { sb_ = r_ >> 2; db_ = r_ & 3; colbase_ = 1024 + h_ * DQK + db_ * 64; dst_ = KWT + ((size_t)ch_ * DQK + db_ * 64) * LC + sb_ * 64; } \
        else { const int r2_ = r_ - 16; sb_ = r2_ >> 3; db_ = r2_ & 7; colbase_ = 2048 + h_ * DV + db_ * 64; dst_ = VT + ((size_t)ch_ * DV + db_ * 64) * LC + sb_ * 64; } \
        src_ = PROJ + (row0_ + sb_ * 64 + sr) * NPROJ + colbase_ + 8 * dc; } while (0)
#define MP_STAGE(v_, ch_, isK_, sb_, db_, dst_) do { const float mend_ = SM[(size_t)ch_ * LC + LC - 1]; \
        _Pragma("unroll") for (int i = 0; i < 8; ++i) { const int s_ = sr + 8 * i; const float w_ = isK_ ? __expf(SA[(size_t)ch_ * LC + sb_ * 64 + s_] - mend_) : 1.0f; \
            LAS float* d_ = scr + s_ * 65 + 8 * dc; \
            d_[0] = bf_lo(v_[i].x) * w_; d_[1] = bf_hi(v_[i].x) * w_; d_[2] = bf_lo(v_[i].y) * w_; d_[3] = bf_hi(v_[i].y) * w_; d_[4] = bf_lo(v_[i].z) * w_; d_[5] = bf_hi(v_[i].z) * w_; d_[6] = bf_lo(v_[i].w) * w_; d_[7] = bf_hi(v_[i].w) * w_; } \
        LDS_WAIT(); \
        if (isK_) { float a_ = 0.f; _Pragma("unroll 16") for (int s2_ = 0; s2_ < 64; ++s2_) a_ += scr[s2_ * 65 + lane]; DNP[((size_t)ch_ * 4 + sb_) * DQK + db_ * 64 + lane] = a_; } \
        tr_out(scr, dst_, LC, lane); } while (0)
__device__ __forceinline__ void mp_phase(Frame& F) {
    const int lane = F.lane;
    LAS float* scr = (LAS float*)(F.lds + F.wave * TR_SCR);
    const bf16* PROJ = (const bf16*)(F.ka->ws + WS_PROJ); bf16* KWT = (bf16*)(F.ka->ws + WS_KWT); bf16* VT = (bf16*)(F.ka->ws + WS_H);
    const float* SA = (const float*)(F.ka->ws + WS_SA); const float* SM = (const float*)(F.ka->ws + WS_SM); float* DNP = (float*)(F.ka->ws + WS_DNP);
    const int gw = F.bid * NWAVES + F.wave, NGW = GRID * NWAVES;
    const int dc = lane & 7, sr = lane >> 3;
    for (int it = gw; it < NCHH * 48; it += 2 * NGW) {
        const int it2 = it + NGW; const bool two = it2 < NCHH * 48;
        int chA, sbA, dbA, chB = 0, sbB = 0, dbB = 0; bool kA, kB = false; const bf16 *srcA, *srcB = nullptr; bf16 *dstA, *dstB = nullptr;
        MP_DECODE(it, chA, kA, sbA, dbA, srcA, dstA);
        if (two) MP_DECODE(it2, chB, kB, sbB, dbB, srcB, dstB);
        v4u va[8], vb[8];
#pragma unroll
        for (int i = 0; i < 8; ++i) va[i] = *(const GAS v4u*)(srcA + (size_t)(8 * i) * NPROJ);
        if (two) {
#pragma unroll
            for (int i = 0; i < 8; ++i) vb[i] = *(const GAS v4u*)(srcB + (size_t)(8 * i) * NPROJ); }
        MP_STAGE(va, chA, kA, sbA, dbA, dstA);
        if (two) MP_STAGE(vb, chB, kB, sbB, dbB, dstB);
    }
}
#undef MP_DECODE
#undef MP_STAGE
__device__ __forceinline__ void mc_phase(Frame& F) {
    const float* SM = (const float*)(F.ka->ws + WS_SM);
    const int gtid = F.bid * NTHREADS + F.tid, NT = GRID * NTHREADS;
    for (int idx = gtid; idx < NBH * 16384; idx += NT) {
        const int bh = idx >> 14, vec = idx & 16383;
        const GAS v4u* p = (const GAS v4u*)((const char*)F.ka->out) + (size_t)bh * NCH * 16384 + vec;
        GAS v4u* q = (GAS v4u*)((char*)F.ka->out + OUT_CT2) + (size_t)bh * NCH * 16384 + vec;
        const float* me = SM + (size_t)bh * SEQ + LC - 1;
        float st[8];
#pragma unroll
        for (int e = 0; e < 8; ++e) st[e] = 0.f;
        float mprev = 0.f;
        for (int c0 = 0; c0 < NCH; c0 += 8) {
            v4u x[8];
#pragma unroll
            for (int j = 0; j < 8; ++j) x[j] = p[(size_t)(c0 + j) * 16384];
#pragma unroll
            for (int j = 0; j < 8; ++j) { const float mcur = me[(size_t)(c0 + j) * LC]; const float dec = __expf(mprev - mcur); mprev = mcur;
                v4u o; o.x = pk2(st[0], st[1]); o.y = pk2(st[2], st[3]); o.z = pk2(st[4], st[5]); o.w = pk2(st[6], st[7]);
                q[(size_t)(c0 + j) * 16384] = o;
                st[0] = st[0] * dec + bf_lo(x[j].x); st[1] = st[1] * dec + bf_hi(x[j].x); st[2] = st[2] * dec + bf_lo(x[j].y); st[3] = st[3] * dec + bf_hi(x[j].y);
                st[4] = st[4] * dec + bf_lo(x[j].z); st[5] = st[5] * dec + bf_hi(x[j].z); st[6] = st[6] * dec + bf_lo(x[j].w); st[7] = st[7] * dec + bf_hi(x[j].w); }
        }
    }
    const float* DNP = (const float*)(F.ka->ws + WS_DNP); float* NST = (float*)(F.ka->ws + WS_NST);
    const int gw = F.bid * NWAVES + F.wave, NGW = GRID * NWAVES;
    for (int task = gw; task < NBH * DQK; task += NGW) {
        const int bh = task >> 8, d = task & 255, c = F.lane & 31, ch = bh * NCH + c;
        const float* dp = DNP + (size_t)ch * 4 * DQK + d;
        const float dn = (dp[0] + dp[DQK]) + (dp[2 * DQK] + dp[3 * DQK]);
        const float* me = SM + (size_t)bh * SEQ + LC - 1;
        float n = 0.f, mprev = 0.f, nout = 0.f;
#pragma unroll
        for (int cc = 0; cc < NCH; ++cc) { const float mcur = me[(size_t)cc * LC]; const float dec = __expf(mprev - mcur); mprev = mcur;
            const float dnc = __builtin_bit_cast(float, __builtin_amdgcn_readlane(__builtin_bit_cast(int, dn), cc));
            nout = (c == cc) ? n : nout; n = n * dec + dnc; }
        if (F.lane < NCH) NST[(size_t)ch * DQK + d] = nout;
    }
}
__device__ __forceinline__ void mn_phase(Frame& F, const float* mnw  ) {
    const int lane = F.lane;
    const bf16* Y = (const bf16*)(F.ka->ws + WS_Y); bf16* YO = (bf16*)(F.ka->ws + WS_H); const bf16* PROJ = (const bf16*)(F.ka->ws + WS_PROJ); const bf16* P = (const bf16*)(F.ka->ws + WS_P);
    const float* NST = (const float*)(F.ka->ws + WS_NST); const float* SM = (const float*)(F.ka->ws + WS_SM); const float* SF = (const float*)(F.ka->ws + WS_SF);
    const int gw = F.bid * NWAVES + F.wave, rows_per = MROWS / (GRID * NWAVES);
    f32x4 w0[MH], w1[MH];
#pragma unroll
    for (int h = 0; h < MH; ++h) { w0[h] = *(const GAS f32x4*)(mnw + h * DV + 8 * lane); w1[h] = *(const GAS f32x4*)(mnw + h * DV + 8 * lane + 4); }
    const int rowA = gw * rows_per, bW = rowA >> 13, ccW = (rowA & (SEQ - 1)) >> 8;
    f32x4 nn[MH]; float mc[MH];
#pragma unroll
    for (int h = 0; h < MH; ++h) { const int bh = bW * MH + h, ch = bh * NCH + ccW;
        nn[h] = *(const GAS f32x4*)(NST + (size_t)ch * DQK + 4 * lane); mc[h] = ccW ? SM[(size_t)bh * SEQ + ccW * LC - 1] : 0.f; }
    v4u nuN[MH], ogN[MH]; v2u ppN[MH], qqN[MH]; float mtN[MH], ftN[MH];
#define MN_LOAD(row_) do { const int t_ = (row_) & (SEQ - 1), tl_ = t_ & 255; _Pragma("unroll") for (int h = 0; h < MH; ++h) { const int bh = bW * MH + h, ch = bh * NCH + ccW; \
            nuN[h] = *(const GAS v4u*)(Y + (size_t)(row_) * DM + h * DV + 8 * lane); ogN[h] = *(const GAS v4u*)(PROJ + (size_t)(row_) * NPROJ + 4096 + h * DV + 8 * lane); \
            ppN[h] = *(const GAS v2u*)(P + ((size_t)ch * LC + tl_) * LC + 4 * lane); qqN[h] = *(const GAS v2u*)(PROJ + (size_t)(row_) * NPROJ + h * DQK + 4 * lane); \
            mtN[h] = SM[(size_t)bh * SEQ + t_]; ftN[h] = SF[(size_t)bh * SEQ + t_]; } } while (0)
    MN_LOAD(rowA);
    for (int row = rowA; row < rowA + rows_per; ++row) {
        v4u nu[MH], og[MH]; v2u pp[MH], qq[MH]; float mt[MH], ft[MH];
#pragma unroll
        for (int h = 0; h < MH; ++h) { nu[h] = nuN[h]; og[h] = ogN[h]; pp[h] = ppN[h]; qq[h] = qqN[h]; mt[h] = mtN[h]; ft[h] = ftN[h]; }
        { const int rn_ = (row + 1 < rowA + rows_per) ? row + 1 : row; MN_LOAD(rn_); }
#pragma unroll
        for (int h = 0; h < MH; ++h) {
            float nv[8] = {bf_lo(nu[h].x), bf_hi(nu[h].x), bf_lo(nu[h].y), bf_hi(nu[h].y), bf_lo(nu[h].z), bf_hi(nu[h].z), bf_lo(nu[h].w), bf_hi(nu[h].w)};
            float ov[8] = {bf_lo(og[h].x), bf_hi(og[h].x), bf_lo(og[h].y), bf_hi(og[h].y), bf_lo(og[h].z), bf_hi(og[h].z), bf_lo(og[h].w), bf_hi(og[h].w)};
            float ps = (bf_lo(pp[h].x) + bf_hi(pp[h].x)) + (bf_lo(pp[h].y) + bf_hi(pp[h].y));
            float qn = (bf_lo(qq[h].x) * nn[h].x + bf_hi(qq[h].x) * nn[h].y) + (bf_lo(qq[h].y) * nn[h].z + bf_hi(qq[h].y) * nn[h].w);
            float sq = 0.f;
#pragma unroll
            for (int e = 0; e < 8; ++e) sq += nv[e] * nv[e];
            ps = wave_sum(ps); qn = wave_sum(qn); sq = wave_sum(sq);
            const float den = ps + SCALE_M * __expf(mc[h] - mt[h]) * qn;
            const float hden = fmaxf(fabsf(den), __expf(-(ft[h] + mt[h])));
            const float inv = 1.0f / hden;
            const float rr = rsqrtf(sq * inv * inv * (1.0f / DV) + EPS) * inv;
            const float wv[8] = {w0[h].x, w0[h].y, w0[h].z, w0[h].w, w1[h].x, w1[h].y, w1[h].z, w1[h].w};
            float yv[8];
#pragma unroll
            for (int e = 0; e < 8; ++e) yv[e] = nv[e] * rr * wv[e] * sigmoidf_(ov[e]);
            v4u o; o.x = pk2(yv[0], yv[1]); o.y = pk2(yv[2], yv[3]); o.z = pk2(yv[4], yv[5]); o.w = pk2(yv[6], yv[7]);
            *(GAS v4u*)(YO + (size_t)row * DM + h * DV + 8 * lane) = o;
        }
    }
#undef MN_LOAD
}

__device__ __forceinline__ void attn_phase(Frame& F, const int jf, const int rep) {
    char* lds = (char*)F.lds;
    const fa::bf16* PROJ = (const fa::bf16*)(F.ka->ws + WS_PROJ); fa::bf16* Y = (fa::bf16*)(F.ka->ws + WS_Y); const float* NB = (const float*)(F.ka->ws + WS_NB);
    constexpr int NQB = SEQ / fa::QB, TOTAL = NQB * BATCH * FH;
    static_assert(GRID <= TOTAL, "every workgroup owns a first item");
    unsigned* ctr = (unsigned*)(F.ka->ws + WS_CTL) + CW_Q + jf * 2 + rep;
    unsigned* kn = (unsigned*)(F.ka->ws + WS_CTL) + CW_KN + jf * 256;
    volatile LAS unsigned* MISC = (volatile LAS unsigned*)(F.lds + MISC_OFF);
#define FA_DECODE(I_, bh_, qb_) do { qb_ = NQB - 1 - ((I_) >> 6); bh_ = (I_) & 63; } while (0)
#define FA_REF(r_, bh_, qb_) do { const int b_ = (bh_) >> 4, h_ = (bh_) & 15; const size_t rb_ = (size_t)b_ * SEQ; \
        r_.Q = PROJ + (rb_ + (size_t)(qb_) * fa::QB) * NPROJ + h_ * 128; r_.K = PROJ + rb_ * NPROJ + 2048 + h_ * 128; r_.V = PROJ + rb_ * NPROJ + 4096 + h_ * 128; \
        r_.O = Y + (rb_ + (size_t)(qb_) * fa::QB) * DM + h_ * 128; r_.P0 = (qb_) * fa::QB; } while (0)
    int bh, qb; FA_DECODE(F.bid, bh, qb);
    fa::BlockRef cur; FA_REF(cur, bh, qb);
    fa::Seam S;
    fa::prime(cur, lds, S, F.tid);
    for (;;) {
        float k2 = 0.f;
        {
            int tb = F.tid; asm volatile("" : "+v"(tb));
            const GAS f32x4* src = (const GAS f32x4*)(NB + (size_t)bh * SEQ);
            LAS f32x4* dstb = (LAS f32x4*)(F.lds + fa::BIAS_OFF);
#pragma unroll
            for (int i = 0; i < 4; ++i) dstb[tb + i * NTHREADS] = src[tb + i * NTHREADS];
            if (tb == 0) MISC[32] = (unsigned)GRID + atomicAdd(ctr, 1u);
            const int rowq = cur.P0 + (tb >> 6) * fa::QBLK + (tb & 31);
            const GAS unsigned char* kr = (const GAS unsigned char*)cur.K + (size_t)rowq * (NPROJ * 2) + ((tb >> 5) & 1) * 16;
            const float nbi = *(const GAS float*)(NB + (size_t)bh * SEQ + rowq);
            float ss = 0.f, dd = 0.f;
#pragma unroll
            for (int d0 = 0; d0 < 8; ++d0) { const v4u w = *reinterpret_cast<const v4u*>(&S.qr[d0]); const v4u kw = *(const GAS v4u*)(kr + d0 * 32);
#pragma unroll
                for (int e = 0; e < 4; ++e) { const float lo = bf_lo(w[e]), hi = bf_hi(w[e]); ss = fmaf(lo, lo, ss); ss = fmaf(hi, hi, ss);
                    dd = fmaf(lo, bf_lo(kw[e]), dd); dd = fmaf(hi, bf_hi(kw[e]), dd); } }
            ss += __shfl_xor(ss, 32); dd += __shfl_xor(dd, 32);
            float vi = dd + nbi;
#pragma unroll
            for (int o = 1; o < 32; o <<= 1) { ss = fmaxf(ss, __shfl_xor(ss, o)); vi = fminf(vi, __shfl_xor(vi, o)); }
            if ((tb & 63) == 0) { MISC[40 + (tb >> 6)] = __float_as_uint(ss); MISC[48 + (tb >> 6)] = __float_as_uint(vi); }
#pragma unroll
            for (int w = 0; w < 4; ++w) k2 += __uint_as_float(__hip_atomic_load(kn + bh * 4 + w, RLX_AGENT));
            fa::head_issue(cur, lds, S, tb);
        }
        __syncthreads();
        const int nidx = __builtin_amdgcn_readfirstlane((int)MISC[32]);
        int T0;
        {
            float q2 = 0.f, vmin = __uint_as_float(MISC[48]);
#pragma unroll
            for (int w = 0; w < NWAVES; ++w) { q2 = fmaxf(q2, __uint_as_float(MISC[40 + w])); vmin = fminf(vmin, __uint_as_float(MISC[48 + w])); }
            const float TH = 1.02f * __builtin_sqrtf(q2 * k2) + (fa::THR / fa::SCALE + 128.0f / (1.4426950408889634f * fa::SCALE) + 2.0f);
            const LAS float* bl = (const LAS float*)(F.lds + fa::BIAS_OFF);
            const int ln = fa::lane_now(), NTL = (cur.P0 >> 6);
            const bool live0 = !(ln < NTL && vmin - bl[64 * ln + 63] > TH), live1 = !(ln + 64 < NTL && vmin - bl[64 * ln + 64 * 64 + 63] > TH);
            const unsigned long long b0 = __ballot(live0), b1 = __ballot(live1);
            T0 = b0 ? __builtin_ctzll(b0) : 64 + __builtin_ctzll(b1);
            T0 = __builtin_amdgcn_readfirstlane(T0);
        }
        const bool last = nidx >= TOTAL;
        int bhn = bh, qbn = qb;
        fa::BlockRef nxt; if (last) nxt = cur; else { FA_DECODE(nidx, bhn, qbn); FA_REF(nxt, bhn, qbn); }
        fa::block(cur, nxt, lds, S, F.tid, T0);
        if (last) break;
        cur = nxt; bh = bhn; qb = qbn;
    }
#undef FA_DECODE
#undef FA_REF
}

__device__ __forceinline__ void final_norm_phase(Frame& F) {
    const int lane = F.lane;
    const int gw = F.bid * NWAVES + F.wave, rows_per = MROWS / (GRID * NWAVES);
    f32x4 pw[8];
#pragma unroll
    for (int j = 0; j < 8; ++j) pw[j] = *(const GAS f32x4*)(F.ka->in[15] + 256 * j + 4 * lane);
    const unsigned short* X = (const unsigned short*)(F.ka->ws + WS_X);
    const int rA = gw * rows_per, rE = rA + rows_per;
    v2u a[8], b[8];
#pragma unroll
    for (int j = 0; j < 8; ++j) { a[j] = *(const GAS v2u*)(X + (size_t)rA * DM + 256 * j + 4 * lane); b[j] = *(const GAS v2u*)(X + (size_t)(rA + 1) * DM + 256 * j + 4 * lane); }
    for (int r = rA; r < rE; ++r) {
        const int rn = (r + 2 < rE) ? r + 2 : rE - 1;
        v2u c[8];
#pragma unroll
        for (int j = 0; j < 8; ++j) c[j] = *(const GAS v2u*)(X + (size_t)rn * DM + 256 * j + 4 * lane);
        f32x4 y[8]; float s = 0.f;
#pragma unroll
        for (int j = 0; j < 8; ++j) { y[j] = unpk_h4(a[j]); s += (y[j].x * y[j].x + y[j].y * y[j].y) + (y[j].z * y[j].z + y[j].w * y[j].w); }
        const float rs = rsqrtf(wave_sum(s) * (1.0f / DM) + EPS);
#pragma unroll
        for (int j = 0; j < 8; ++j) *(GAS f32x4*)(F.ka->out + (size_t)r * DM + 256 * j + 4 * lane) = y[j] * rs * pw[j];
#pragma unroll
        for (int j = 0; j < 8; ++j) { a[j] = b[j]; b[j] = c[j]; }
    }
}
#ifndef G4_AH
#define G4_AH 8
#endif
#ifndef G2_AH
#define G2_AH 8
#endif
#ifndef G3_WGM
#define G3_WGM 4
#endif
#ifndef WGM_RES
#define WGM_RES 4
#endif
constexpr int PH_PER_LAYER = 11, PH_FINAL = 1 + DEPTH * PH_PER_LAYER, PH_END = PH_FINAL + 1;
__global__ void __launch_bounds__(NTHREADS, 2) fwd(Args args) {
    extern __shared__ __attribute__((aligned(16))) unsigned char lds[];
    Frame F;
    F.lds = (LAS unsigned char*)lds;
    F.wave0 = __builtin_amdgcn_readfirstlane((int)threadIdx.x >> 6); refresh(F);
    volatile LAS unsigned* MISC = (volatile LAS unsigned*)(F.lds + MISC_OFF);
    for (int u = F.tid; u < 256; u += NTHREADS) MISC[u] = 0u;
    __syncthreads();
    XcdBarrier bar = xcd_barrier_post((unsigned*)(F.ka->ws + WS_CTL) + CW_BAR + args.li * XCD_BAR_WORDS, MISC + 8);
#ifndef PH_MASK
#define PH_MASK 0xFFFFFFFFu
#endif
#define EN(n) ((PH_MASK >> (n)) & 1u)
#ifndef REP_MASK
#define REP_MASK 0u
#endif
#define PHASE_BEGIN(n) _Pragma("unroll 1") for (int rep = 0; rep < (((REP_MASK >> (n)) & 1u) ? 2 : 1); ++rep) { if (rep) xcd_barrier(bar); refresh(F);
#define PHASE_END }
#define IN(k) (F.ka->ph_lo <= (k) && (k) < F.ka->ph_hi)
#define WS (F.ka->ws)
#define OUT (F.ka->out)
#define AIN(k) (F.ka->in[k])
#define SEAM(k, k2) do { if (IN(k) && IN(k2)) xcd_barrier(bar); } while (0)

    PHASE_BEGIN(0) if (EN(0) && IN(0)) { p0_prologue(F); } PHASE_END
    SEAM(0, 1);

    for (int l = 0; l < DEPTH; ++l) {
        const int pb = 1 + PH_PER_LAYER * l, j = l >> 1; const bool isM = (l & 1) == 0;
#define MOD_L ((const float*)(WS + WS_MOD) + (size_t)l * BATCH * MODW)
#define X16 ((char*)(WS + WS_X))
#define X16B ((char*)(WS + WS_X2))
#define Hb ((const char*)(WS + WS_H))
#define PROJb ((const char*)(WS + WS_PROJ))
#define Yb ((const char*)(WS + WS_Y))

        PHASE_BEGIN(1) if (EN(1) && IN(pb + 0)) {
            if (l == 0) norm_phase<8, true>(F, AIN(0), AIN(4) + (size_t)l * DM, MOD_L, 0, DM, (const float*)(WS + WS_WG) + (size_t)j * 8 * DM);
            else if (isM) norm_phase<8, false>(F, X16, AIN(4) + (size_t)l * DM, MOD_L, 0, DM, (const float*)(WS + WS_WG) + (size_t)j * 8 * DM);
            else norm_phase<16, false>(F, X16, AIN(4) + (size_t)l * DM, MOD_L, 0, DM, (const float*)(WS + WS_WGF) + (size_t)j * 16 * DM);
        } PHASE_END
        SEAM(pb + 0, pb + 1);

        PHASE_BEGIN(2) if (EN(2) && IN(pb + 1)) {
            if (isM) { if (F.bid < NBH) mlstm_gate_scan(F, F.bid, AIN(7) + j * 8); }
            else { if (F.bid < BATCH * FH) fox_gate_scan(F, F.bid, AIN(11) + j * 16); }
            __syncthreads();
            pg8::Gemm g{(unsigned)(DM * 2), (unsigned)(DM * 2), 0u, 0u, DM, 0};
            MainSched S; S.T.init(MROWS, NPROJ, GRID, F.bid); S.A = Hb;
            S.B = isM ? (const char*)(WS + WS_WINM) + (size_t)j * NPROJ * DM * 2 : (const char*)(WS + WS_WINF) + (size_t)j * NPROJ * DM * 2;
            S.O = (char*)(WS + WS_PROJ); S.tA = (size_t)256 * DM * 2; S.tB = (size_t)256 * DM * 2; S.tOm = (size_t)256 * NPROJ * 2; S.tOn = 256 * 2;
            EpiStore E; E.ldo = NPROJ; E.kn = isM ? nullptr : (unsigned*)(WS + WS_CTL) + CW_KN + j * 256;
            pg8::gemm_phase<EpiStore, MainSched, true, true, false>(F.lds, g, S, E, F.tid);
        } PHASE_END
        SEAM(pb + 1, pb + 2);

        if (isM) {
            PHASE_BEGIN(3) if (EN(3) && IN(pb + 2)) { mp_phase(F); } PHASE_END
            SEAM(pb + 2, pb + 3);
            PHASE_BEGIN(4) if (EN(4) && IN(pb + 3)) {
                { pg8::Gemm g{(unsigned)(NPROJ * 2), (unsigned)(NPROJ * 2), 0u, 0u, DQK, 0};
                  SchedS S; S.G = GRID; S.c = F.bid; S.proj = PROJb; S.P = (char*)(WS + WS_P);
                  EpiS E; E.SA = (const float*)(WS + WS_SA); E.SM = (const float*)(WS + WS_SM);
                  pg8::gemm_phase<EpiS, SchedS, true, true, false>(F.lds, g, S, E, F.tid); }
                { pg8::Gemm g{(unsigned)(LC * 2), (unsigned)(LC * 2), 0u, 0u, LC, 0};
                  SchedDC S; S.G = GRID; S.c = F.bid; S.VT = Hb; S.KWT = (const char*)(WS + WS_KWT); S.CT = (char*)OUT;
                  EpiStore E; E.ldo = DQK; E.kn = nullptr;
                  pg8::gemm_phase<EpiStore, SchedDC, true, true, false>(F.lds, g, S, E, F.tid); }
            } PHASE_END
            SEAM(pb + 3, pb + 4);
            PHASE_BEGIN(5) if (EN(5) && IN(pb + 4)) { mc_phase(F); } PHASE_END
            SEAM(pb + 4, pb + 5);
            PHASE_BEGIN(6) if (EN(6) && IN(pb + 5)) {
                pg8::Gemm g{(unsigned)(NPROJ * 2), (unsigned)(DQK * 2), (unsigned)(LC * 2), (unsigned)(LC * 2), DQK + LC, DQK / 64};
                SchedNum S; S.G = GRID; S.c = F.bid; S.proj = PROJb; S.CT = (const char*)OUT + OUT_CT2; S.P = (const char*)(WS + WS_P); S.VT = Hb; S.Y = (char*)(WS + WS_Y);
                EpiNum E; E.ldo = DM; E.SM = (const float*)(WS + WS_SM);
                pg8::gemm_phase<EpiNum, SchedNum, true, true, true>(F.lds, g, S, E, F.tid);
            } PHASE_END
            SEAM(pb + 5, pb + 6);
            PHASE_BEGIN(7) if (EN(7) && IN(pb + 6)) { mn_phase(F, AIN(8) + (size_t)j * DM); } PHASE_END
            SEAM(pb + 6, pb + 7);
        } else {
            PHASE_BEGIN(8) if (EN(8) && IN(pb + 2)) { attn_phase(F, j, rep); } PHASE_END
            SEAM(pb + 2, pb + 7);
        }

        PHASE_BEGIN(9) if (EN(9) && IN(pb + 7)) {
            pg8::Gemm g{(unsigned)(DM * 2), (unsigned)(DM * 2), 0u, 0u, DM, 0};
            MainSched S; S.T.init(MROWS, DM, GRID, F.bid, WGM_RES); S.A = isM ? Hb : Yb;
            S.B = isM ? (const char*)(WS + WS_WOUTM) + (size_t)j * DM * DM * 2 : (const char*)(WS + WS_WOUTF) + (size_t)j * DM * DM * 2;
            S.O = rep ? (char*)(WS + WS_KWT) : X16B; S.tA = (size_t)256 * DM * 2; S.tB = (size_t)256 * DM * 2; S.tOm = (size_t)256 * DM * 2; S.tOn = 256 * 2;
            if (l == 0 && !rep) { EpiResid<true> E; E.gate_l = MOD_L + 2 * DM; E.xin = AIN(0); pg8::gemm_phase<EpiResid<true>, MainSched, true, true, false>(F.lds, g, S, E, F.tid); }
            else { EpiResid<false, G2_AH> E; E.gate_l = MOD_L + 2 * DM; E.xin = X16; pg8::gemm_phase<EpiResid<false, G2_AH>, MainSched, true, true, false>(F.lds, g, S, E, F.tid); }
        } PHASE_END
        SEAM(pb + 7, pb + 8);

        PHASE_BEGIN(10) if (EN(10) && IN(pb + 8)) { norm_phase<0, false>(F, X16B, AIN(5) + (size_t)l * DM, MOD_L, 3 * DM, 4 * DM, nullptr); } PHASE_END
        SEAM(pb + 8, pb + 9);

        PHASE_BEGIN(11) if (EN(11) && IN(pb + 9)) {
            pg8::Gemm g{(unsigned)(DM * 2), (unsigned)(DM * 2), 0u, 0u, DM, 0};
            MainSched S; S.T.init(MROWS, 2 * DFF, GRID, F.bid, G3_WGM); S.A = Hb; S.B = (const char*)(WS + WS_WGU) + (size_t)l * 2 * DFF * DM * 2;
            S.O = (char*)(WS + WS_PROJ); S.tA = (size_t)256 * DM * 2; S.tB = (size_t)256 * DM * 2; S.tOm = (size_t)256 * DFF * 2; S.tOn = 128 * 2;
            EpiSwiglu E;
            pg8::gemm_phase<EpiSwiglu, MainSched, true, true, false>(F.lds, g, S, E, F.tid);
        } PHASE_END
        SEAM(pb + 9, pb + 10);

        PHASE_BEGIN(12) if (EN(12) && IN(pb + 10)) {
            pg8::Gemm g{(unsigned)(DFF * 2), (unsigned)(DFF * 2), 0u, 0u, DFF, 0};
            MainSched S; S.T.init(MROWS, DM, GRID, F.bid, WGM_RES, 1); S.A = PROJb; S.B = (const char*)(WS + WS_WDN) + (size_t)l * DM * DFF * 2;
            S.O = rep ? (char*)(WS + WS_KWT) : X16; S.tA = (size_t)256 * DFF * 2; S.tB = (size_t)256 * DFF * 2; S.tOm = (size_t)256 * DM * 2; S.tOn = 256 * 2;
            EpiResid<false, G4_AH> E; E.gate_l = MOD_L + 5 * DM; E.xin = X16B;
            pg8::gemm_phase<EpiResid<false, G4_AH>, MainSched, true, true, false>(F.lds, g, S, E, F.tid);
        } PHASE_END
        SEAM(pb + 10, pb + 11);
    }

    PHASE_BEGIN(13) if (EN(13) && IN(PH_FINAL)) { final_norm_phase(F); } PHASE_END
#undef IN
#undef WS
#undef OUT
#undef AIN
#undef MOD_L
#undef X16
#undef X16B
#undef Hb
#undef PROJb
#undef Yb
#undef SEAM
}

#ifndef MK_CUTS
#define MK_CUTS {0, PH_END}
#endif
extern "C" void kernel_launch(void* const* d_in, const int* in_sizes, int n_in, void* d_out, int out_size, void* d_ws, size_t ws_size, hipStream_t stream) {
    static int grid = 0;
    if (grid == 0) {
        if (n_in != 16 || in_sizes[0] != MROWS * DM || out_size != MROWS * DM || ws_size < WS_END) {
            fprintf(stderr, "kernel_launch: shape/workspace mismatch (n_in %d, in0 %d, out %d, ws %zu, need %zu); nothing launched\n", n_in, n_in > 0 ? in_sizes[0] : -1, out_size, ws_size, (size_t)WS_END); grid = -1; return; }
        int dev = 0, cus = 0, per_cu = 0;
        if (hipGetDevice(&dev) != hipSuccess || hipDeviceGetAttribute(&cus, hipDeviceAttributeMultiprocessorCount, dev) != hipSuccess) { grid = -1; return; }
        if (hipFuncSetAttribute((const void*)fwd, hipFuncAttributeMaxDynamicSharedMemorySize, LDS_BYTES) != hipSuccess) { fprintf(stderr, "kernel_launch: hipFuncSetAttribute failed\n"); grid = -1; return; }
        if (hipOccupancyMaxActiveBlocksPerMultiprocessor(&per_cu, (const void*)fwd, NTHREADS, LDS_BYTES) != hipSuccess || per_cu < 1) { fprintf(stderr, "kernel_launch: occupancy query says %d\n", per_cu); (void)hipGetLastError(); }
        if (cus != 256) { fprintf(stderr, "kernel_launch: built for 256 CUs, device has %d; nothing launched\n", cus); grid = -1; return; }
        grid = GRID;
    }
    if (grid < 0) return;
    if (hipMemsetAsync((char*)d_ws + WS_CTL, 0, CTL_ZERO_BYTES, stream) != hipSuccess) return;
    Args a{};
    for (int i = 0; i < 16; ++i) a.in[i] = (const float*)d_in[i];
    a.out = (float*)d_out; a.ws = (unsigned char*)d_ws; a.pad = 0;
    const int cuts[] = MK_CUTS; constexpr int ncut = sizeof(cuts) / sizeof(int);
    for (int li = 0; li + 1 < ncut; ++li) {
        a.ph_lo = cuts[li]; a.ph_hi = cuts[li + 1]; a.li = li;
        hipLaunchKernelGGL(fwd, dim3(grid), dim3(NTHREADS), LDS_BYTES, stream, a);
        const hipError_t le = hipPeekAtLastError();
        if (le != hipSuccess) { fprintf(stderr, "kernel_launch: launch %d failed: %s\n", li, hipGetErrorName(le)); break; }
    }
}
```

```cpp
#include <hip/hip_runtime.h>
#include <hip/hip_bf16.h>
#include <cstdio>
#include <cstdint>
#include <cstddef>
namespace pg8 {
#define PG8_LAS __attribute__((address_space(3)))
typedef unsigned short bf16_t;
typedef short bf16x8 __attribute__((ext_vector_type(8)));
typedef float f32x4 __attribute__((ext_vector_type(4)));
typedef float f32x2 __attribute__((ext_vector_type(2)));
typedef unsigned u32x4 __attribute__((ext_vector_type(4)));
constexpr int BM = 256, BK = 64, HALF = 128, HTB = HALF * BK * 2  , STAGE_BYTES = 8 * HTB, NXCD = 8, WGM = 4;

__host__ __device__ __forceinline__ int lds_byte(int r, int c) { const int st = (r >> 4) * 2 + (c >> 5), rr = r & 15, cc = c & 31, ob = rr * 64 + cc * 2; return st * 1024 + (ob ^ (((ob >> 9) & 1) << 5)); }
__host__ __device__ __forceinline__ void stage_rc(int b, int& R, int& C) { const int st = b / 1024, sb = b % 1024, swz = sb ^ (((sb >> 9) & 1) << 5); R = (st >> 1) * 16 + swz / 64; C = (st & 1) * 32 + (swz % 64) / 2; }
__host__ __device__ __forceinline__ int perm32(int rho) { const int n = rho >> 4, i = rho & 15; return 8 * (i >> 2) + 4 * n + (i & 3); }

struct Unit { const char* A; const char* B; const char* A1; const char* B1; char* O; int pm, pn; };
struct Gemm { unsigned lda, ldb, lda1, ldb1; int K, nt0; };

struct TileOrder {
    int nM, nN, nwg, G, c, wgm, rev;
    __device__ void init(int M, int N, int G_, int c_, int wgm_ = WGM, int rev_ = 0) { nM = M / BM; nN = N / BM; nwg = nM * nN; G = G_; c = c_; wgm = wgm_; rev = rev_; }
    __device__ bool tile(int i, int& pm, int& pn) const {
        const long L = (long)i * G + c; if (L >= nwg) return false;
        int wgid = (int)L; { const int q = nwg / NXCD, r = nwg % NXCD, xcd = wgid % NXCD, off = wgid / NXCD; wgid = (xcd < r ? xcd * (q + 1) : r * (q + 1) + (xcd - r) * q) + off; }
        if (rev) { const int q = nwg / NXCD, x = wgid / q; wgid = x * q + (q - 1 - (wgid - x * q)); }
        const int nig = wgm * nN, gid = wgid / nig, fm = gid * wgm, gsz = (nM - fm) < wgm ? (nM - fm) : wgm;
        pm = fm + ((wgid % nig) % gsz); pn = (wgid % nig) / gsz; return true;
    }
};

__device__ __forceinline__ unsigned cvt_pk_bf16(float lo, float hi) { unsigned r; asm volatile("v_cvt_pk_bf16_f32 %0, %1, %2" : "=v"(r) : "v"(lo), "v"(hi)); return r; }


template <class Epi, class Sched, bool ALIGN_EPI = false, bool SP2 = true, bool SPLIT = false>
__device__ __forceinline__ void gemm_phase(PG8_LAS unsigned char* lds, const Gemm g, const Sched& S, const Epi& E, const int tid  ) {
    const int wid = __builtin_amdgcn_readfirstlane(tid >> 6), lane = tid & 63, wr = wid >> 2, wc = wid & 3, fr = lane & 15, fq = lane >> 4;
    const int K = g.K, nt = K / BK;
    unsigned voffA[2], voffB[2], voffA1[2], voffB1[2];
#pragma unroll
    for (int i = 0; i < 2; ++i) { int R, C; stage_rc(tid * 16 + i * 8192, R, C); const int Rb = Epi::PERM ? ((R & ~31) + perm32(R & 31)) : R;
        voffA[i] = (unsigned)R * g.lda + (unsigned)C * 2u; voffB[i] = (unsigned)Rb * g.ldb + (unsigned)C * 2u;
        voffA1[i] = SPLIT ? (unsigned)R * g.lda1 + (unsigned)C * 2u : 0u; voffB1[i] = SPLIT ? (unsigned)Rb * g.ldb1 + (unsigned)C * 2u : 0u; }
    const size_t kstep = (size_t)(BK * 2);
    const unsigned hstepA = (unsigned)HALF * g.lda, hstepB = (unsigned)HALF * g.ldb;
    const unsigned hstepA1 = SPLIT ? (unsigned)HALF * g.lda1 : 0u, hstepB1 = SPLIT ? (unsigned)HALF * g.ldb1 : 0u;
    const unsigned ldsw = (unsigned)wid * 1024u;
    const int aoff = lds_byte(wr * 64 + fr, fq * 8), boff = lds_byte(wc * 32 + fr, fq * 8);
#define PG8_SA(b, h) (((b) * 2 + (h)) * HTB)
#define PG8_SB(b, h) ((4 + (b) * 2 + (h)) * HTB)
#define PG8_STAGE(bufoff, gbase, v0, v1) do { \
        __builtin_amdgcn_global_load_lds((const unsigned*)((const char*)(gbase) + (v0)), (PG8_LAS unsigned*)(lds + (bufoff) + ldsw), 16, 0, 0); \
        __builtin_amdgcn_global_load_lds((const unsigned*)((const char*)(gbase) + (v1)), (PG8_LAS unsigned*)(lds + (bufoff) + ldsw + 8192), 16, 0, 0); } while (0)
#define PG8_LDA(dst, b, h) do { _Pragma("unroll") for (int m = 0; m < 4; ++m) _Pragma("unroll") for (int k = 0; k < 2; ++k) dst[m][k] = *(const PG8_LAS bf16x8*)(lds + PG8_SA(b, h) + aoff + m * 2048 + k * 1024); } while (0)
#define PG8_LDB(dst, b, h) do { _Pragma("unroll") for (int n = 0; n < 2; ++n) _Pragma("unroll") for (int k = 0; k < 2; ++k) dst[n][k] = *(const PG8_LAS bf16x8*)(lds + PG8_SB(b, h) + boff + n * 2048 + k * 1024); } while (0)
#define PG8_MMA(ai, bj, At, Bt) do { __builtin_amdgcn_s_setprio(1); _Pragma("unroll") for (int m = 0; m < 4; ++m) _Pragma("unroll") for (int n = 0; n < 2; ++n) _Pragma("unroll") for (int k = 0; k < 2; ++k) \
        acc[ai][bj][m][n] = __builtin_amdgcn_mfma_f32_16x16x32_bf16(Bt[n][k], At[m][k], acc[ai][bj][m][n], 0, 0, 0); __builtin_amdgcn_s_setprio(0); } while (0)
#define PG8_WAIT_V(n) asm volatile("s_waitcnt vmcnt(" #n ")" ::: "memory")
#define PG8_WAIT_L(n) asm volatile("s_waitcnt lgkmcnt(" #n ")" ::: "memory")
#define PG8_BAR __builtin_amdgcn_s_barrier()
#define PG8_SCHED __builtin_amdgcn_sched_barrier(0)
    Unit cur, nxt; int ui = 0;
    if (!S.next(0, cur)) return;
    f32x4 acc[2][2][4][2];
#pragma unroll
    for (int a = 0; a < 2; ++a)
#pragma unroll
        for (int b = 0; b < 2; ++b)
#pragma unroll
            for (int m = 0; m < 4; ++m)
#pragma unroll
                for (int n = 0; n < 2; ++n) acc[a][b][m][n] = (f32x4){0.f, 0.f, 0.f, 0.f};
    bf16x8 At[4][2], B0[2][2], B1[2][2];
    const char* cA = cur.A; const char* cB = cur.B; const char* cA1 = SPLIT ? cur.A1 : nullptr; const char* cB1 = SPLIT ? cur.B1 : nullptr;
    if constexpr (SP2) {
        PG8_STAGE(PG8_SB(0, 0), cB, voffB[0], voffB[1]); PG8_STAGE(PG8_SB(0, 1), cB + hstepB, voffB[0], voffB[1]); PG8_STAGE(PG8_SA(0, 0), cA, voffA[0], voffA[1]); PG8_STAGE(PG8_SA(0, 1), cA + hstepA, voffA[0], voffA[1]);
        if (wr == 1) PG8_BAR;
        PG8_WAIT_V(2); PG8_BAR;
        PG8_STAGE(PG8_SB(1, 0), cB + kstep, voffB[0], voffB[1]); PG8_STAGE(PG8_SA(1, 0), cA + kstep, voffA[0], voffA[1]); PG8_STAGE(PG8_SB(1, 1), cB + hstepB + kstep, voffB[0], voffB[1]);
        PG8_WAIT_V(6); PG8_BAR;
    } else {
        PG8_STAGE(PG8_SB(0, 0), cB, voffB[0], voffB[1]); PG8_STAGE(PG8_SA(0, 0), cA, voffA[0], voffA[1]); PG8_STAGE(PG8_SB(0, 1), cB + hstepB, voffB[0], voffB[1]); PG8_STAGE(PG8_SA(0, 1), cA + hstepA, voffA[0], voffA[1]);
        if (wr == 1) PG8_BAR;
        PG8_WAIT_V(4); PG8_BAR;
        PG8_STAGE(PG8_SB(1, 0), cB + kstep, voffB[0], voffB[1]); PG8_STAGE(PG8_SA(1, 0), cA + kstep, voffA[0], voffA[1]); PG8_STAGE(PG8_SB(1, 1), cB + hstepB + kstep, voffB[0], voffB[1]);
        PG8_WAIT_V(6); PG8_BAR;
    }
    for (;;) {
        const bool has_next = S.next(ui + 1, nxt);
        const char* nA = has_next ? nxt.A : cA; const char* nB = has_next ? nxt.B : cB;
#pragma unroll 1
        for (int t = 0; t < nt; t += 2) {
            const bool last = (t == nt - 2);
            const char *a1, *a2, *b2; unsigned hA1, hA2, hB2; unsigned vA1_0, vA1_1, vA2_0, vA2_1, vB2_0, vB2_1;
            if constexpr (SPLIT) {
                const bool s1 = (t + 1) < g.nt0, s2 = last || (t + 2) < g.nt0;
                a1 = s1 ? cA + (size_t)(t + 1) * kstep : cA1 + (size_t)(t + 1 - g.nt0) * kstep; hA1 = s1 ? hstepA : hstepA1; vA1_0 = s1 ? voffA[0] : voffA1[0]; vA1_1 = s1 ? voffA[1] : voffA1[1];
                a2 = last ? nA : (s2 ? cA + (size_t)(t + 2) * kstep : cA1 + (size_t)(t + 2 - g.nt0) * kstep);
                b2 = last ? nB : (s2 ? cB + (size_t)(t + 2) * kstep : cB1 + (size_t)(t + 2 - g.nt0) * kstep);
                hA2 = s2 ? hstepA : hstepA1; hB2 = s2 ? hstepB : hstepB1;
                vA2_0 = s2 ? voffA[0] : voffA1[0]; vA2_1 = s2 ? voffA[1] : voffA1[1]; vB2_0 = s2 ? voffB[0] : voffB1[0]; vB2_1 = s2 ? voffB[1] : voffB1[1];
                if (t == g.nt0) { int le = lane; asm volatile("" : "+v"(le)); E.mid(acc, cur, wr, wc, le & 15, le >> 4, nullptr); }
            } else {
                a1 = cA + (size_t)(t + 1) * kstep; hA1 = hstepA; vA1_0 = voffA[0]; vA1_1 = voffA[1];
                a2 = last ? nA : cA + (size_t)(t + 2) * kstep; b2 = last ? nB : cB + (size_t)(t + 2) * kstep; hA2 = hstepA; hB2 = hstepB;
                vA2_0 = voffA[0]; vA2_1 = voffA[1]; vB2_0 = voffB[0]; vB2_1 = voffB[1];
            }
            const char* a3 = a2 + kstep; const char* b3 = b2 + kstep;
            if constexpr (SP2) {
            PG8_LDB(B0, 0, 0); PG8_LDB(B1, 0, 1); PG8_SCHED; PG8_LDA(At, 0, 0); PG8_STAGE(PG8_SA(1, 1), a1 + hA1, vA1_0, vA1_1);
            PG8_WAIT_V(8); PG8_WAIT_L(0); PG8_BAR; PG8_MMA(0, 0, At, B0); PG8_MMA(0, 1, At, B1); PG8_BAR; PG8_SCHED;
            PG8_LDA(At, 0, 1); PG8_STAGE(PG8_SB(0, 0), b2, vB2_0, vB2_1); PG8_STAGE(PG8_SB(0, 1), b2 + hB2, vB2_0, vB2_1); PG8_STAGE(PG8_SA(0, 0), a2, vA2_0, vA2_1);
            PG8_WAIT_V(8); PG8_WAIT_L(0); PG8_BAR; PG8_MMA(1, 0, At, B0); PG8_MMA(1, 1, At, B1); PG8_BAR; PG8_SCHED;
            PG8_LDB(B0, 1, 0); PG8_LDB(B1, 1, 1); PG8_SCHED; PG8_LDA(At, 1, 0); PG8_STAGE(PG8_SA(0, 1), a2 + hA2, vA2_0, vA2_1);
            PG8_WAIT_V(8); PG8_WAIT_L(0); PG8_BAR; PG8_MMA(0, 0, At, B0); PG8_MMA(0, 1, At, B1); PG8_BAR; PG8_SCHED;
            PG8_LDA(At, 1, 1); PG8_STAGE(PG8_SB(1, 0), b3, vB2_0, vB2_1); PG8_STAGE(PG8_SB(1, 1), b3 + hB2, vB2_0, vB2_1); PG8_STAGE(PG8_SA(1, 0), a3, vA2_0, vA2_1);
            PG8_WAIT_V(8); PG8_WAIT_L(0); PG8_BAR; PG8_MMA(1, 0, At, B0); PG8_MMA(1, 1, At, B1); PG8_BAR; PG8_SCHED;
            } else {
            PG8_LDB(B0, 0, 0); PG8_SCHED; PG8_LDA(At, 0, 0); PG8_STAGE(PG8_SA(1, 1), a1 + hA1, vA1_0, vA1_1);
            PG8_WAIT_L(8); PG8_BAR; PG8_WAIT_L(0); PG8_MMA(0, 0, At, B0); PG8_BAR; PG8_SCHED;
            PG8_LDB(B1, 0, 1); PG8_STAGE(PG8_SB(0, 0), b2, vB2_0, vB2_1);
            PG8_BAR; PG8_WAIT_L(0); PG8_MMA(0, 1, At, B1); PG8_BAR;
            PG8_LDA(At, 0, 1); PG8_STAGE(PG8_SA(0, 0), a2, vA2_0, vA2_1);
            PG8_BAR; PG8_WAIT_L(0); PG8_MMA(1, 0, At, B0); PG8_BAR; PG8_SCHED;
            PG8_STAGE(PG8_SB(0, 1), b2 + hB2, vB2_0, vB2_1);
            PG8_WAIT_V(6); PG8_BAR; PG8_MMA(1, 1, At, B1); PG8_BAR;
            PG8_LDB(B0, 1, 0); PG8_SCHED; PG8_LDA(At, 1, 0); PG8_STAGE(PG8_SA(0, 1), a2 + hA2, vA2_0, vA2_1);
            PG8_WAIT_L(8); PG8_BAR; PG8_WAIT_L(0); PG8_MMA(0, 0, At, B0); PG8_BAR; PG8_SCHED;
            PG8_LDB(B1, 1, 1); PG8_STAGE(PG8_SB(1, 0), b3, vB2_0, vB2_1);
            PG8_BAR; PG8_WAIT_L(0); PG8_MMA(0, 1, At, B1); PG8_BAR;
            PG8_LDA(At, 1, 1); PG8_STAGE(PG8_SA(1, 0), a3, vA2_0, vA2_1);
            PG8_BAR; PG8_WAIT_L(0); PG8_MMA(1, 0, At, B0); PG8_BAR; PG8_SCHED;
            PG8_STAGE(PG8_SB(1, 1), b3 + hB2, vB2_0, vB2_1);
            PG8_WAIT_V(6); PG8_BAR; PG8_MMA(1, 1, At, B1); PG8_BAR;
            }
        }
        if constexpr (ALIGN_EPI) { if (wr == 0) PG8_BAR; }
        { int le = lane; asm volatile("" : "+v"(le)); E(acc, cur, wr, wc, le & 15, le >> 4, lds + PG8_SA(1, 1) + ldsw); }
        if (!has_next) break;
#pragma unroll
        for (int a = 0; a < 2; ++a)
#pragma unroll
            for (int b = 0; b < 2; ++b)
#pragma unroll
                for (int m = 0; m < 4; ++m)
#pragma unroll
                    for (int n = 0; n < 2; ++n) acc[a][b][m][n] = (f32x4){0.f, 0.f, 0.f, 0.f};
        cur = nxt; cA = nA; cB = nB; if constexpr (SPLIT) { cA1 = cur.A1; cB1 = cur.B1; } ++ui;
        if constexpr (ALIGN_EPI) { if (wr == 1) PG8_BAR; }
    }
    PG8_WAIT_V(0);
    if constexpr (!ALIGN_EPI) { if (wr == 0) PG8_BAR; }
    PG8_BAR;
#undef PG8_SA
#undef PG8_SB
#undef PG8_STAGE
#undef PG8_LDA
#undef PG8_LDB
#undef PG8_MMA
#undef PG8_WAIT_V
#undef PG8_WAIT_L
#undef PG8_BAR
#undef PG8_SCHED
}
}
namespace fa {
using bf16 = __hip_bfloat16;
typedef short bf16x8 __attribute__((ext_vector_type(8)));
typedef short s16x4 __attribute__((ext_vector_type(4)));
typedef float f32x16 __attribute__((ext_vector_type(16)));
typedef float f32x4 __attribute__((ext_vector_type(4)));
typedef unsigned u32x4 __attribute__((ext_vector_type(4)));
constexpr int D = 128;
constexpr int QPITCH = 6144, OPITCH = 2048;
constexpr float SCALE = 0.08838834764831845f;
constexpr float THR = 4.f;
constexpr int NW = 8, QBLK = 32, KVBLK = 64, QB = NW * QBLK;
constexpr int SHM_V = KVBLK * D * 2, SHM_K = KVBLK * D * 2;
constexpr int NBUF = 3;
constexpr int BIAS_OFF = NBUF * SHM_V + NBUF * SHM_K + NW * 64 * 4;
constexpr int LDS_BYTES = BIAS_OFF + 8192 * 4;

#define KSWZ(row, colB) ((row) * 256 + ((colB) ^ (((row) & 7) << 4)))
#define SBAR() __builtin_amdgcn_sched_barrier(0)
__device__ __forceinline__ int v_st(int k, int c) { const int kk = (k & ~0xC) | ((k & 4) << 1) | ((k & 8) >> 1); return ((kk >> 3) * 4 + (c >> 5)) * 512 + ((kk & 7) * 32 + (c & 31)) * 2; }
__device__ __forceinline__ int v_rd_base(int lane) { return ((lane & 3) << 3) | (((lane >> 2) & 3) << 6) | (((lane >> 4) & 1) << 5) | (((lane >> 5) & 1) << 8); }
constexpr int v_rd_off(int d0, int ks, int half) { return d0 * 512 + ks * 4096 + half * 2048; }
__device__ __forceinline__ int lane_now() { int t; asm volatile("v_mbcnt_lo_u32_b32 %0, -1, 0\n\tv_mbcnt_hi_u32_b32 %0, -1, %0" : "=v"(t)); return t; }
__device__ __forceinline__ int crow(int r, int hi) { return (r & 3) + 8 * (r >> 2) + 4 * hi; }
__device__ __forceinline__ unsigned cvtpk(float lo, float hi) { unsigned r; asm volatile("v_cvt_pk_bf16_f32 %0, %1, %2" : "=v"(r) : "v"(lo), "v"(hi)); return r; }
__device__ __forceinline__ bf16x8 load8(const bf16* p) { return *reinterpret_cast<const bf16x8*>(p); }
__device__ __forceinline__ void mask_tile(f32x16& p0, f32x16& p1, int dq) {
    const float NEG = -__builtin_inff();
#pragma unroll
    for (int r = 0; r < 16; ++r) {
        const int c = (r & 3) + 8 * (r >> 2);
        if (dq - c < 0) p0[r] = NEG;
        if (dq - c - 32 < 0) p1[r] = NEG;
    }
}
__device__ __forceinline__ bool partialSM(f32x16& p0, f32x16& p1, float& m_reg, float& mn, float& alpha) {
    float pmax = p0[0]; for (int r = 1; r < 16; ++r) pmax = fmaxf(pmax, p0[r]); for (int r = 0; r < 16; ++r) pmax = fmaxf(pmax, p1[r]);
    { auto rr = __builtin_amdgcn_permlane32_swap(__float_as_uint(pmax), __float_as_uint(pmax), false, false);
      pmax = fmaxf(__uint_as_float(rr[0]), __uint_as_float(rr[1])); }
    constexpr float C2 = 1.4426950408889634f * SCALE;
    if (__all((pmax - m_reg) * C2 < -127.f)) { mn = m_reg; alpha = 1.f; return true; }
    if (__builtin_expect(__all((pmax - m_reg) * SCALE <= THR), 1)) { mn = m_reg; alpha = 1.f; }
    else { mn = fmaxf(m_reg, pmax); alpha = __builtin_amdgcn_exp2f((m_reg - mn) * C2); m_reg = mn; }
    const float mnL = -mn * C2;
    for (int r = 0; r < 16; ++r) p0[r] = fmaf(p0[r], C2, mnL); for (int r = 0; r < 16; ++r) p1[r] = fmaf(p1[r], C2, mnL);
    for (int r = 0; r < 16; ++r) p0[r] = __builtin_amdgcn_exp2f(p0[r]);
    return false;
}
__device__ __forceinline__ void finishSM(f32x16& p0, f32x16& p1, float alpha, float& l_reg, bf16x8& pa0, bf16x8& pa1, bf16x8& pa2, bf16x8& pa3, const bool dead = false) {
    for (int r = 0; r < 16; ++r) p1[r] = __builtin_amdgcn_exp2f(p1[r]);
    float ps = 0; for (int r = 0; r < 16; ++r) ps += p0[r]; for (int r = 0; r < 16; ++r) ps += p1[r];
    { auto rr = __builtin_amdgcn_permlane32_swap(__float_as_uint(ps), __float_as_uint(ps), false, false);
      ps = __uint_as_float(rr[0]) + __uint_as_float(rr[1]); }
    l_reg = dead ? l_reg : l_reg * alpha + ps;
#define PK4(P, B_, OUT) do { unsigned a0 = cvtpk(P[B_+0], P[B_+1]), a1 = cvtpk(P[B_+2], P[B_+3]);                          \
        unsigned b0 = cvtpk(P[B_+4], P[B_+5]), b1 = cvtpk(P[B_+6], P[B_+7]);                                             \
        auto r0 = __builtin_amdgcn_permlane32_swap(a0, b0, false, false); auto r1 = __builtin_amdgcn_permlane32_swap(a1, b1, false, false); \
        u32x4 w = {r0[0], r1[0], r0[1], r1[1]}; OUT = *reinterpret_cast<bf16x8*>(&w); } while (0)
    PK4(p0, 0, pa0); PK4(p0, 8, pa1); PK4(p1, 0, pa2); PK4(p1, 8, pa3);
#undef PK4
}
__device__ __forceinline__ void qkt(int KB, f32x16& p0, f32x16& p1, const char* K_lds, int r32, int hi, const bf16x8* qr, const char* bias_t) {
    { const int ln_ = lane_now(); bias_t += ((ln_ >> 5) << 4);
#pragma unroll
      for (int g4 = 0; g4 < 4; ++g4) { const f32x4 b0 = *reinterpret_cast<const f32x4*>(bias_t + g4 * 32); const f32x4 b1 = *reinterpret_cast<const f32x4*>(bias_t + 128 + g4 * 32);
        p0[4 * g4 + 0] = b0[0]; p0[4 * g4 + 1] = b0[1]; p0[4 * g4 + 2] = b0[2]; p0[4 * g4 + 3] = b0[3];
        p1[4 * g4 + 0] = b1[0]; p1[4 * g4 + 1] = b1[1]; p1[4 * g4 + 2] = b1[2]; p1[4 * g4 + 3] = b1[3]; } }
    unsigned k0a = (unsigned)(uintptr_t)K_lds + (unsigned)(KB * SHM_K) + (unsigned)KSWZ(r32, hi * 16);
    asm volatile("" : "+v"(k0a));
    const char* kb[4];
#pragma unroll
    for (int dd = 0; dd < 4; ++dd) kb[dd] = (const char*)(__attribute__((address_space(3))) const char*)(uintptr_t)(k0a ^ (unsigned)(dd << 5));
#pragma unroll
    for (int d0 = 0; d0 < 8; ++d0) { const char* a = kb[d0 & 3] + (d0 >> 2) * 128;
        bf16x8 b0 = *reinterpret_cast<const bf16x8*>(a);
        bf16x8 b1 = *reinterpret_cast<const bf16x8*>(a + 32 * 256);
        p0 = __builtin_amdgcn_mfma_f32_32x32x16_bf16(b0, qr[d0], p0, 0, 0, 0);
        p1 = __builtin_amdgcn_mfma_f32_32x32x16_bf16(b1, qr[d0], p1, 0, 0, 0); }
}
__device__ __forceinline__ void add_bias(f32x16& p0, f32x16& p1, const char* bias_t) {
#pragma unroll
    for (int g4 = 0; g4 < 4; ++g4) { const f32x4 b0 = *reinterpret_cast<const f32x4*>(bias_t + g4 * 32);
        p0[4 * g4 + 0] += b0[0]; p0[4 * g4 + 1] += b0[1]; p0[4 * g4 + 2] += b0[2]; p0[4 * g4 + 3] += b0[3]; }
#pragma unroll
    for (int g4 = 0; g4 < 4; ++g4) { const f32x4 b1 = *reinterpret_cast<const f32x4*>(bias_t + 128 + g4 * 32);
        p1[4 * g4 + 0] += b1[0]; p1[4 * g4 + 1] += b1[1]; p1[4 * g4 + 2] += b1[2]; p1[4 * g4 + 3] += b1[3]; }
}
__device__ __forceinline__ void pv_tile(int VB, f32x16* o, int vb0, bf16x8 pa0, bf16x8 pa1, bf16x8 pa2, bf16x8 pa3) {
    const int vbt = vb0 + VB * SHM_V;
#define TRRD(dst, off) asm volatile("ds_read_b64_tr_b16 %0, %1 offset:%2" : "=&v"(dst) : "v"(vbt), "i"(off) : "memory")
#define PV_D0(d0) do { s16x4 l0, l1, l2, l3, h0, h1, h2, h3; constexpr int b_ = v_rd_off(d0, 0, 0);     \
        TRRD(l0, b_); TRRD(h0, b_ + 2048); TRRD(l1, b_ + 4096); TRRD(h1, b_ + 6144); TRRD(l2, b_ + 8192); TRRD(h2, b_ + 10240); TRRD(l3, b_ + 12288); TRRD(h3, b_ + 14336); \
        asm volatile("s_waitcnt lgkmcnt(0)" ::: "memory"); SBAR();   \
        o[d0] = __builtin_amdgcn_mfma_f32_32x32x16_bf16(pa0, (bf16x8){l0[0], l0[1], l0[2], l0[3], h0[0], h0[1], h0[2], h0[3]}, o[d0], 0, 0, 0);   \
        o[d0] = __builtin_amdgcn_mfma_f32_32x32x16_bf16(pa1, (bf16x8){l1[0], l1[1], l1[2], l1[3], h1[0], h1[1], h1[2], h1[3]}, o[d0], 0, 0, 0);   \
        o[d0] = __builtin_amdgcn_mfma_f32_32x32x16_bf16(pa2, (bf16x8){l2[0], l2[1], l2[2], l2[3], h2[0], h2[1], h2[2], h2[3]}, o[d0], 0, 0, 0);   \
        o[d0] = __builtin_amdgcn_mfma_f32_32x32x16_bf16(pa3, (bf16x8){l3[0], l3[1], l3[2], l3[3], h3[0], h3[1], h3[2], h3[3]}, o[d0], 0, 0, 0); } while (0)
    PV_D0(0); PV_D0(1); PV_D0(2); PV_D0(3);
#undef PV_D0
#undef TRRD
}

struct BlockRef { const bf16* Q; const bf16* K; const bf16* V; bf16* O; int P0; };
struct Seam { bf16x8 qr[8]; bf16x8 st_v0, st_v1, st_k0, st_k1; };
#define KVROW(p, k0, rr) ((const char*)(p) + (size_t)((k0) + (rr)) * (QPITCH * 2))
#define VMW() asm volatile("s_waitcnt vmcnt(0)" ::: "memory")
#define VMWN(n) asm volatile("s_waitcnt vmcnt(%0)" :: "i"(n) : "memory")
#define SLOAD_H(Kp, Vp, k0) do { S.st_v0 = *(const bf16x8*)(KVROW(Vp, k0, 0) + voffKV); S.st_v1 = *(const bf16x8*)(KVROW(Vp, k0, 32) + voffKV);              \
                         S.st_k0 = *(const bf16x8*)(KVROW(Kp, k0, 0) + voffKV); S.st_k1 = *(const bf16x8*)(KVROW(Kp, k0, 32) + voffKV); } while (0)
#define SWRITE_HK(bf) do { *(bf16x8*)(K_lds + (bf) * SHM_K + kws) = S.st_k0; *(bf16x8*)(K_lds + (bf) * SHM_K + kws + 32 * 256) = S.st_k1; } while (0)
#define SWRITE_HV(bf) do { *(bf16x8*)(V_lds + (bf) * SHM_V + vst0) = S.st_v0; *(bf16x8*)(V_lds + (bf) * SHM_V + vst1) = S.st_v1; } while (0)
#define SWRITE_H(bf) do { SWRITE_HV(bf); SWRITE_HK(bf); } while (0)
__device__ __forceinline__ void prime(const BlockRef& cur, char* lds, Seam& S, const int tid) {
    const int wid = __builtin_amdgcn_readfirstlane(tid >> 6), lane = tid & 63, r32 = lane & 31, hi = lane >> 5;
    const int sr = tid >> 4, sc = (tid & 15) * 8, kws = KSWZ(sr, sc * 2); char* K_lds = lds + NBUF * SHM_V;
    const unsigned voffKV = (unsigned)((sr * QPITCH + sc) * 2), voffQ = (unsigned)((r32 * QPITCH + hi * 8) * 2);
    { const char* qb = (const char*)cur.Q + (size_t)(wid * QBLK) * (QPITCH * 2);
#pragma unroll
      for (int d0 = 0; d0 < 8; ++d0) S.qr[d0] = *(const bf16x8*)(qb + d0 * 32 + voffQ); }
    SLOAD_H(cur.K, cur.V, (cur.P0 + QB - 1) / KVBLK * KVBLK); VMW(); SWRITE_HK(0);
    __syncthreads();
}
__device__ __forceinline__ void head_issue(const BlockRef& cur, char* lds, Seam& S, const int tid) {
    const int sr = tid >> 4, sc = (tid & 15) * 8, vst0 = v_st(sr, sc), vst1 = vst0 + 8192; char* V_lds = lds;
    const unsigned voffKV = (unsigned)((sr * QPITCH + sc) * 2);
    SWRITE_HV(0); SBAR();
    SLOAD_H(cur.K, cur.V, cur.P0 + QB - 2 * KVBLK); SBAR();
}
__device__ __forceinline__ void block(const BlockRef& cur, const BlockRef& nxt, char* lds, Seam& S, const int tid, const int T0) {
    const int wid = __builtin_amdgcn_readfirstlane(tid >> 6), lane = tid & 63, r32 = lane & 31, hi = lane >> 5;
    const int NTF = (cur.P0 + QB - 1) / KVBLK + 1;
    const int NT = NTF - T0;
    const int qlo = cur.P0 + wid * QBLK;
    char* V_lds = lds; char* K_lds = lds + NBUF * SHM_V;
    float* ws = (float*)(lds + NBUF * SHM_V + NBUF * SHM_K) + wid * 64; float* li_l = ws, * al_l = ws + 32;
    const char* bias_b = lds + BIAS_OFF;
    float m_reg = -1e30f, l_reg = 0; f32x16 o[4] = {};
    const int sr = tid >> 4, sc = (tid & 15) * 8, vst0 = v_st(sr, sc), vst1 = vst0 + 8192  , kws = KSWZ(sr, sc * 2);
    const int vb0 = (int)(uintptr_t)V_lds + v_rd_base(lane);
    const unsigned voffKV = (unsigned)((sr * QPITCH + sc) * 2), voffQ = (unsigned)((r32 * QPITCH + hi * 8) * 2);
    const bf16* Kh = cur.K; const bf16* Vh = cur.V;
#define RESC(a) do { if (__any((a) < 1.f)) { if (hi == 0) al_l[r32] = (a); asm volatile("s_waitcnt lgkmcnt(0)" ::: "memory");              \
                     for (int d_ = 0; d_ < 4; ++d_) for (int r = 0; r < 16; ++r) o[d_][r] *= al_l[crow(r, hi)]; } } while (0)
#define KBASE(t) ((NTF - 1 - (t)) * KVBLK)
#define MASKT(P0_, P1_, t) do { const int kb_ = KBASE(t); const int ln_ = lane_now(); \
        if (kb_ + KVBLK - 1 > qlo) mask_tile(P0_, P1_, qlo + (ln_ & 31) - 4 * (ln_ >> 5) - kb_); } while (0)
    constexpr int NQL = 8;
#define SEAM_K0() do { VMWN(NQL); SWRITE_HK(0); SBAR(); } while (0)
    f32x16 pA0, pA1, pB0, pB1; float mnA, mnB, alA, alB; bf16x8 pa0, pa1, pa2, pa3;
    SBAR(); qkt(0, pA0, pA1, K_lds, r32, hi, S.qr, bias_b + KBASE(0) * 4);
    bool deadA, deadB = true;
    MASKT(pA0, pA1, 0); deadA = partialSM(pA0, pA1, m_reg, mnA, alA);
    if (NT > 1) { VMW(); SWRITE_H(1); }
    __syncthreads();
#define HALF_STEP(PX0, PX1, mnX, alX, dX, PY0, PY1, alY, dY, t) do {                                                           \
        const int vbi_ = bt == 0 ? 2 : bt - 1, sbi_ = bt == 2 ? 0 : bt + 1;                                                    \
        SBAR();                                                                                                               \
        qkt(bt, PX0, PX1, K_lds, r32, hi, S.qr, bias_b + KBASE(t) * 4);                                                       \
        finishSM(PY0, PY1, alY, l_reg, pa0, pa1, pa2, pa3, dY);                                                              \
        SBAR();                                                                                                               \
        if ((t) + 1 < NT) { SLOAD_H(Kh, Vh, KBASE((t) + 1)); SBAR(); }                                                        \
        if (!(dY)) pv_tile(vbi_, o, vb0, pa0, pa1, pa2, pa3);                                                                 \
        MASKT(PX0, PX1, (t)); dX = partialSM(PX0, PX1, m_reg, mnX, alX);                                                      \
        if ((t) + 1 < NT) { VMW(); SWRITE_H(sbi_); }                                                                          \
        RESC(alX); __syncthreads(); bt = sbi_; } while (0)
    int bt = 1;
    for (int t = 1; t + 1 < NT; t += 2) {
        HALF_STEP(pB0, pB1, mnB, alB, deadB, pA0, pA1, alA, deadA, t);
        HALF_STEP(pA0, pA1, mnA, alA, deadA, pB0, pB1, alB, deadB, t + 1);
    }
    const bool even = (NT & 1) == 0;
    const int vba = bt == 0 ? 2 : bt - 1;
    if (even) { SBAR(); qkt(bt, pB0, pB1, K_lds, r32, hi, S.qr, bias_b + KBASE(NT - 1) * 4); SBAR(); }
    SLOAD_H(nxt.K, nxt.V, (nxt.P0 + QB - 1) / KVBLK * KVBLK); SBAR();
    { int tq = tid; asm volatile("" : "+v"(tq));
      const unsigned voffQ = (unsigned)((((tq & 31) * QPITCH) + ((tq >> 5) & 1) * 8) * 2);
      const char* qb = (const char*)nxt.Q + (size_t)(wid * QBLK) * (QPITCH * 2);
#pragma unroll
      for (int d0 = 0; d0 < 8; ++d0) S.qr[d0] = *(const bf16x8*)(qb + d0 * 32 + voffQ); }
    SBAR();
    if (!deadA) { finishSM(pA0, pA1, alA, l_reg, pa0, pa1, pa2, pa3); SBAR();
        pv_tile(vba, o, vb0, pa0, pa1, pa2, pa3); }
    if (even) { MASKT(pB0, pB1, NT - 1); deadB = partialSM(pB0, pB1, m_reg, mnB, alB); __syncthreads(); RESC(alB);
        if (!deadB) { finishSM(pB0, pB1, alB, l_reg, pa0, pa1, pa2, pa3); SBAR(); pv_tile(bt, o, vb0, pa0, pa1, pa2, pa3); } }
    SBAR(); SEAM_K0();
    if (hi == 0) li_l[r32] = l_reg; asm volatile("s_waitcnt lgkmcnt(0)" ::: "memory");
    int te = tid; asm volatile("" : "+v"(te));
    const int r32e = te & 31, hie = (te >> 5) & 1;
    float rli[16];
#pragma unroll
    for (int r = 0; r < 16; ++r) rli[r] = __builtin_amdgcn_rcpf(li_l[crow(r, hie)]);
    char* Ow = (char*)(cur.O + (size_t)(wid * QBLK) * OPITCH);
    const unsigned voff = (unsigned)((4 * hie * OPITCH + r32e) * 2);
#pragma unroll
    for (int r = 0; r < 16; ++r) { char* rb = Ow + (size_t)((r & 3) + 8 * (r >> 2)) * OPITCH * 2;
#pragma unroll
        for (int d0 = 0; d0 < 4; ++d0) { const float v = o[d0][r] * rli[r];
            const float vn = __shfl_xor(v, 1);
            if ((r32e & 1) == 0) *(unsigned*)(rb + d0 * 64 + voff) = cvtpk(v, vn); } }
    __syncthreads();
#undef RESC
#undef KBASE
#undef MASKT
#undef SEAM_K0
#undef HALF_STEP
}
#undef KVROW
#undef VMW
#undef VMWN
#undef SLOAD_H
#undef SWRITE_HK
#undef SWRITE_HV
#undef SWRITE_H
}
constexpr int NWAVES = 8, NTHREADS = 512, GRID = 256;
constexpr int BATCH = 4, SEQ = 8192, DM = 2048, DEPTH = 4, MROWS = BATCH * SEQ;
constexpr int MH = 4, DQK = 256, DV = 512, MLSTM_INW = 6152, NPROJ = 6144;
constexpr int FH = 16, FOX_INW = 6160;
constexpr int DFF = 5632, MODW = 6 * DM;
constexpr int LC = 256, NCH = SEQ / LC, NBH = BATCH * MH, NCHH = NBH * NCH;
constexpr float EPS = 1e-6f, SOFTCAP = 15.0f, SCALE_M = 0.0625f  , SCALE_A = 0.08838834764831845f  ;

constexpr size_t MiB = 1u << 20;
constexpr size_t WS_CTL = 0, CTL_ZERO_BYTES = 1 * MiB;
constexpr size_t WS_MOD = 1 * MiB;
constexpr size_t WS_WG = 3 * MiB;
constexpr size_t WS_WGF = WS_WG + 2 * 8 * 2048 * 4;
constexpr size_t WS_SCAN = 4 * MiB;
constexpr size_t WS_SA = WS_SCAN, WS_SM = WS_SA + 512 * 1024, WS_SF = WS_SM + 512 * 1024, WS_NB = WS_SF + 512 * 1024, WS_NST = WS_NB + 2 * MiB;
constexpr size_t WS_DNP = 10 * MiB;
constexpr size_t WS_GPRE = 8 * MiB;
constexpr size_t WS_WINM = 16 * MiB, WS_WINF = 64 * MiB, WS_WOUTM = 112 * MiB, WS_WOUTF = 128 * MiB, WS_WGU = 144 * MiB, WS_WDN = 320 * MiB;
constexpr size_t WS_H = 408 * MiB;
constexpr size_t WS_PROJ = 536 * MiB;
constexpr size_t WS_Y = 920 * MiB;
constexpr size_t WS_KWT = 1048 * MiB;
constexpr size_t WS_P = 1112 * MiB;
constexpr size_t WS_X = 1176 * MiB;
constexpr size_t WS_X2 = 1304 * MiB;
constexpr size_t WS_END = 1432 * MiB;
constexpr size_t OUT_CT2 = 128 * MiB;
constexpr int CW_KN = 256;
constexpr int CW_Q = 1024;
constexpr int CW_BAR = 4096;

constexpr int LDS_BYTES = 147456;
constexpr int MISC_OFF = LDS_BYTES - 1024;
constexpr int TR_SCR = 64 * 65 * 4;
static_assert(NWAVES * TR_SCR <= MISC_OFF && fa::LDS_BYTES <= MISC_OFF && pg8::STAGE_BYTES <= MISC_OFF, "LDS map");

#define GAS __attribute__((address_space(1)))
#define LAS __attribute__((address_space(3)))
typedef unsigned short bf16;
typedef unsigned v4u __attribute__((ext_vector_type(4)));
typedef unsigned v2u __attribute__((ext_vector_type(2)));
typedef float f32x4 __attribute__((ext_vector_type(4)));
typedef GAS unsigned gu32;
#define RLX_AGENT __ATOMIC_RELAXED, __HIP_MEMORY_SCOPE_AGENT
#define LDS_WAIT() asm volatile("s_waitcnt lgkmcnt(0)" ::: "memory")
#define VM_WAIT() asm volatile("s_waitcnt vmcnt(0)" ::: "memory")
__device__ __forceinline__ unsigned pk2(float lo, float hi) { unsigned r; asm volatile("v_cvt_pk_bf16_f32 %0, %1, %2" : "=v"(r) : "v"(lo), "v"(hi)); return r; }
__device__ __forceinline__ float bf_lo(unsigned w) { return __uint_as_float(w << 16); }
__device__ __forceinline__ float bf_hi(unsigned w) { return __uint_as_float(w & 0xffff0000u); }
__device__ __forceinline__ float h_lo(unsigned w) { return (float)__builtin_bit_cast(_Float16, (unsigned short)(w & 0xffffu)); }
__device__ __forceinline__ float h_hi(unsigned w) { return (float)__builtin_bit_cast(_Float16, (unsigned short)(w >> 16)); }
__device__ __forceinline__ unsigned pkh2(float lo, float hi) { const unsigned short a = __builtin_bit_cast(unsigned short, (_Float16)lo), b = __builtin_bit_cast(unsigned short, (_Float16)hi); return (unsigned)a | ((unsigned)b << 16); }
__device__ __forceinline__ f32x4 unpk_h4(v2u w) { const unsigned wx = w.x, wy = w.y; return (f32x4){h_lo(wx), h_hi(wx), h_lo(wy), h_hi(wy)}; }
__device__ __forceinline__ float wave_sum(float v) {
#pragma unroll
    for (int o = 1; o < 64; o <<= 1) v += __shfl_xor(v, o);
    return v;
}
__device__ __forceinline__ float sigmoidf_(float x) { return 1.0f / (1.0f + __expf(-x)); }
__device__ __forceinline__ float log1p01_(float e) { return e < 0.0078125f ? e * (1.0f + e * (-0.5f + e * (1.0f / 3.0f))) : __logf(1.0f + e); }
__device__ __forceinline__ float logsigmoidf_(float x) { return fminf(x, 0.f) - log1p01_(__expf(-fabsf(x))); }
__device__ __forceinline__ float tanhf_(float x) { const float e = __expf(-2.0f * fabsf(x)); const float t = (1.0f - e) / (1.0f + e); return x < 0.f ? -t : t; }

#define XB_TMO      128
#define XB_XCNT(j)  (256  + 64 * (j))
#define XB_XSUB(j)  (1280 + 64 * (j))
#define XB_XGEN(j)  (2304 + 64 * (j))
#define XB_TOP      3328
#define XB_TOPGEN   3392
#define XCD_BAR_WORDS 3456
#define XB_SPIN_CAP (1u << 18)
__device__ __forceinline__ unsigned xb_ld(unsigned* p)              { return __hip_atomic_load(p, __ATOMIC_RELAXED, __HIP_MEMORY_SCOPE_AGENT); }
__device__ __forceinline__ unsigned xb_add(unsigned* p, unsigned v) { return __hip_atomic_fetch_add(p, v, __ATOMIC_RELAXED, __HIP_MEMORY_SCOPE_AGENT); }
__device__ __forceinline__ unsigned xb_xcc_id() { return (unsigned)__builtin_amdgcn_s_getreg((3 << 11) | 20) & 0xFu; }
#define XB_SPIN(cond, bar) do { unsigned _sp = 0; while (cond) { __builtin_amdgcn_s_sleep(1); \
    if ((++_sp & 255u) == 0u) { if (xb_ld(&(bar)[XB_TMO])) break; if (_sp > XB_SPIN_CAP) { atomicAdd(&(bar)[XB_TMO], 1u); break; } } } } while (0)
struct XcdBarrier { unsigned* bar; unsigned x; volatile LAS unsigned* st; };
__device__ __forceinline__ XcdBarrier xcd_barrier_post(unsigned* bar, volatile LAS unsigned* st) {
    XcdBarrier b; b.bar = bar; b.x = xb_xcc_id(); b.st = st;
    if (threadIdx.x == 0) (void)xb_add(&bar[XB_XCNT(b.x)], 1u);
    return b;
}
__device__ __forceinline__ void xcd_barrier_complete(unsigned* bar, unsigned x, unsigned& nloc, unsigned& nx) {
    const unsigned G = gridDim.x * gridDim.y * gridDim.z;
    unsigned sum, cnt, mine, sp = 0u;
    for (;;) {
        sum = 0u; cnt = 0u; mine = 0u;
#pragma unroll
        for (unsigned j = 0; j < 16; ++j) { const unsigned c = xb_ld(&bar[XB_XCNT(j)]); sum += c; cnt += (c > 0u) ? 1u : 0u; mine = (j == x) ? c : mine; }
        if (sum == G) break;
        __builtin_amdgcn_s_sleep(1);
        if ((++sp & 255u) == 0u) { if (xb_ld(&bar[XB_TMO])) break; if (sp > XB_SPIN_CAP) { atomicAdd(&bar[XB_TMO], 1u); break; } }
    }
    nloc = mine > 0u ? mine : 1u; nx = cnt > 0u ? cnt : 1u;
}
__device__ __forceinline__ void xcd_barrier(const XcdBarrier& b) {
    asm volatile("s_waitcnt vmcnt(0)" ::: "memory");
    __syncthreads();
    if (threadIdx.x == 0) {
        unsigned* bar = b.bar;
        __builtin_amdgcn_s_waitcnt(0);
        unsigned nloc = b.st[0], nx = b.st[1];
        if (nloc == 0u) { xcd_barrier_complete(bar, b.x, nloc, nx); b.st[0] = nloc; b.st[1] = nx; }
        const unsigned old = xb_add(&bar[XB_XSUB(b.x)], 1u);
        const unsigned gen = old / nloc;
        if (old + 1u == (gen + 1u) * nloc) {
            __builtin_amdgcn_fence(__ATOMIC_RELEASE, "agent");
            asm volatile("s_waitcnt vmcnt(0)" ::: "memory");
            const unsigned og = xb_add(&bar[XB_TOP], 1u);
            const unsigned tg = og / nx;
            if (og + 1u == (tg + 1u) * nx) xb_add(&bar[XB_TOPGEN], 1u);
            else XB_SPIN(xb_ld(&bar[XB_TOPGEN]) == tg, bar);
            __builtin_amdgcn_fence(__ATOMIC_ACQUIRE, "agent");
            xb_add(&bar[XB_XGEN(b.x)], 1u);
            asm volatile("s_waitcnt vmcnt(0)" ::: "memory");
        } else {
            XB_SPIN(xb_ld(&bar[XB_XGEN(b.x)]) == gen, bar);
            __builtin_amdgcn_fence(__ATOMIC_ACQUIRE, "agent");
            asm volatile("s_waitcnt vmcnt(0)" ::: "memory");
        }
    }
    __syncthreads();
}

struct Args { const float* in[16]; float* out; unsigned char* ws; int ph_lo, ph_hi, li, pad; };
typedef const __attribute__((address_space(4))) Args* KArgP;
__device__ __forceinline__ KArgP kargs() { KArgP p = (KArgP)__builtin_amdgcn_kernarg_segment_ptr(); asm volatile("" : "+s"(p)); return p; }
struct Frame {
    LAS unsigned char* lds;
    int tid, lane, wave, bid, wave0;
    KArgP ka;
};
__device__ __forceinline__ void refresh(Frame& F) { F.ka = kargs();
    int t; asm volatile("v_mbcnt_lo_u32_b32 %0, -1, 0\n\tv_mbcnt_hi_u32_b32 %0, -1, %0" : "=v"(t));
    t += F.wave0 * 64; F.tid = t; { int b_ = (int)blockIdx.x; asm volatile("" : "+s"(b_)); F.bid = b_; } F.lane = t & 63; F.wave = __builtin_amdgcn_readfirstlane(t >> 6); }

__device__ __forceinline__ void tr_out(LAS float* scr, bf16* dst  , size_t ldt, int lane) {
    const int nl = lane & 7, c = lane >> 3;
#pragma unroll
    for (int j = 0; j < 8; ++j) { const int n = nl + 8 * j; const LAS float* s = scr + (8 * c) * 65 + n;
        v4u o; o.x = pk2(s[0], s[65]); o.y = pk2(s[130], s[195]); o.z = pk2(s[260], s[325]); o.w = pk2(s[390], s[455]);
        *(GAS v4u*)(dst + (size_t)n * ldt + 8 * c) = o; }
    LDS_WAIT();
}
__device__ __forceinline__ void tr_load_f32(f32x4 (&v)[16], const float* src  , size_t lds_, int lane) {
    const int cq = lane & 15, rq = lane >> 4;
#pragma unroll
    for (int i = 0; i < 16; ++i) v[i] = *(const GAS f32x4*)(src + (size_t)(rq + 4 * i) * lds_ + 4 * cq);
}
__device__ __forceinline__ void tr_stage_f32(const f32x4 (&v)[16], bf16* dst, size_t ldt, LAS float* scr, int lane) {
    const int cq = lane & 15, rq = lane >> 4;
#pragma unroll
    for (int i = 0; i < 16; ++i) { LAS float* d = scr + (rq + 4 * i) * 65 + 4 * cq; d[0] = v[i].x; d[1] = v[i].y; d[2] = v[i].z; d[3] = v[i].w; }
    LDS_WAIT();
    tr_out(scr, dst, ldt, lane);
}

__device__ __forceinline__ void p0_prologue(Frame& F) {
    const int tid = F.tid, lane = F.lane, wave = F.wave;
    {
        const int u = F.bid;
        if (u < 256) {
            const int l = u >> 6, cg = u & 63;
            f32x4 acc[4];
#pragma unroll
            for (int b = 0; b < 4; ++b) acc[b] = (f32x4){0.f, 0.f, 0.f, 0.f};
            if (lane < 48) {
                const float* W = F.ka->in[2] + (size_t)l * DM * MODW + cg * 192 + 4 * lane;
                const int kb = wave * 256;
                for (int kk = 0; kk < 256; kk += 8) {
                    f32x4 w[8];
#pragma unroll
                    for (int j = 0; j < 8; ++j) w[j] = *(const GAS f32x4*)(W + (size_t)(kb + kk + j) * MODW);
#pragma unroll
                    for (int j = 0; j < 8; ++j) {
#pragma unroll
                        for (int b = 0; b < 4; ++b) { const float cv = F.ka->in[1][b * DM + kb + kk + j]; const float s = cv * sigmoidf_(cv); acc[b] += w[j] * s; } }
                }
            }
            LAS float* red = (LAS float*)F.lds;
            if (lane < 48) {
#pragma unroll
                for (int b = 0; b < 4; ++b) *(LAS f32x4*)(red + (wave * 4 + b) * 192 + 4 * lane) = acc[b]; }
            __syncthreads();
            for (int o = tid; o < 768; o += NTHREADS) { const int b = o / 192, col = o % 192; float s = 0.f;
#pragma unroll
                for (int w = 0; w < 8; ++w) s += red[(w * 4 + b) * 192 + col];
                const int j = cg * 192 + col;
                ((float*)(F.ka->ws + WS_MOD))[(size_t)(l * 4 + b) * MODW + j] = s + F.ka->in[3][(size_t)l * MODW + j]; }
            __syncthreads();
        }
    }
    {
        const int gt = F.bid * NTHREADS + tid;
        if (gt < 2 * 8 * 2048) { const int j = gt / (8 * 2048), r = gt % (8 * 2048), g = r / 2048, k = r % 2048;
            ((float*)(F.ka->ws + WS_WG))[gt] = F.ka->in[6][((size_t)j * DM + k) * MLSTM_INW + NPROJ + g]; }
        else if (gt < 2 * 8 * 2048 + 2 * 16 * 2048) { const int q = gt - 2 * 8 * 2048; const int j = q / (16 * 2048), r = q % (16 * 2048), g = r / 2048, k = r % 2048;
            ((float*)(F.ka->ws + WS_WGF))[q] = F.ka->in[10][((size_t)j * DM + k) * FOX_INW + NPROJ + g]; }
    }
    {
        LAS float* scr = (LAS float*)(F.lds + wave * TR_SCR);
        const int gw = F.bid * NWAVES + wave, NGW = GRID * NWAVES;
        constexpr int I_IN = 32 * 96, I_OUT = 32 * 32, I_GU = 32 * 176, I_DN = 88 * 32;
        constexpr int E0 = 2 * I_IN, E1 = E0 + 2 * I_IN, E2 = E1 + 2 * I_OUT, E3 = E2 + 2 * I_OUT, E4 = E3 + 4 * I_GU, E5 = E4 + 4 * I_DN;
#define P0_DECODE(it_, src_, lds_, dst_, ldt_) do { \
            if ((it_) < E0) { const int j = (it_) / I_IN, r = (it_) % I_IN, kb = r / 96, nb = r % 96; \
                src_ = F.ka->in[6] + ((size_t)j * DM + kb * 64) * MLSTM_INW + nb * 64; lds_ = MLSTM_INW; dst_ = (bf16*)(F.ka->ws + WS_WINM) + ((size_t)j * NPROJ + nb * 64) * DM + kb * 64; ldt_ = DM; } \
            else if ((it_) < E1) { const int q = (it_) - E0, j = q / I_IN, r = q % I_IN, kb = r / 96, nb = r % 96; \
                src_ = F.ka->in[10] + ((size_t)j * DM + kb * 64) * FOX_INW + nb * 64; lds_ = FOX_INW; dst_ = (bf16*)(F.ka->ws + WS_WINF) + ((size_t)j * NPROJ + nb * 64) * DM + kb * 64; ldt_ = DM; } \
            else if ((it_) < E2) { const int q = (it_) - E1, j = q / I_OUT, r = q % I_OUT, kb = r / 32, nb = r % 32; \
                src_ = F.ka->in[9] + ((size_t)j * DM + kb * 64) * DM + nb * 64; lds_ = DM; dst_ = (bf16*)(F.ka->ws + WS_WOUTM) + ((size_t)j * DM + nb * 64) * DM + kb * 64; ldt_ = DM; } \
            else if ((it_) < E3) { const int q = (it_) - E2, j = q / I_OUT, r = q % I_OUT, kb = r / 32, nb = r % 32; \
                src_ = F.ka->in[12] + ((size_t)j * DM + kb * 64) * DM + nb * 64; lds_ = DM; dst_ = (bf16*)(F.ka->ws + WS_WOUTF) + ((size_t)j * DM + nb * 64) * DM + kb * 64; ldt_ = DM; } \
            else if ((it_) < E4) { const int q = (it_) - E3, j = q / I_GU, r = q % I_GU, kb = r / 176, nb = r % 176; \
                const int n0 = nb * 64, jj = n0 < DFF ? n0 : n0 - DFF, drow = (jj >> 7) * 256 + (n0 < DFF ? 0 : 128) + (jj & 127); \
                src_ = F.ka->in[13] + ((size_t)j * DM + kb * 64) * (2 * DFF) + n0; lds_ = 2 * DFF; dst_ = (bf16*)(F.ka->ws + WS_WGU) + ((size_t)j * 2 * DFF + drow) * DM + kb * 64; ldt_ = DM; } \
            else { const int q = (it_) - E4, j = q / I_DN, r = q % I_DN, kb = r / 32, nb = r % 32; \
                src_ = F.ka->in[14] + ((size_t)j * DFF + kb * 64) * DM + nb * 64; lds_ = DM; dst_ = (bf16*)(F.ka->ws + WS_WDN) + ((size_t)j * DM + nb * 64) * DFF + kb * 64; ldt_ = DFF; } } while (0)
        for (int it = gw; it < E5; it += 2 * NGW) {
            const int it2 = it + NGW; const bool two = it2 < E5;
            const float *srcA, *srcB = nullptr; bf16 *dstA, *dstB = nullptr; size_t lsA, lsB = 0, ltA, ltB = 0;
            P0_DECODE(it, srcA, lsA, dstA, ltA);
            if (two) P0_DECODE(it2, srcB, lsB, dstB, ltB);
            f32x4 va[16], vb[16];
            tr_load_f32(va, srcA, lsA, lane);
            if (two) tr_load_f32(vb, srcB, lsB, lane);
            tr_stage_f32(va, dstA, ltA, scr, lane);
            if (two) tr_stage_f32(vb, dstB, ltB, scr, lane);
        }
#undef P0_DECODE
    }
}

template <bool XF> struct XRaw { typedef v2u type; };
template <> struct XRaw<true> { typedef f32x4 type; };
__device__ __forceinline__ f32x4 np_cvt(f32x4 w) { return w; }
__device__ __forceinline__ f32x4 np_cvt(v2u w) { return unpk_h4(w); }
template <int NG, bool XF>
__device__ __forceinline__ void norm_phase(Frame& F, const void* xsrc_, const float* nw, const float* mod_l, int sh_off, int sc_off, const float* Wg) {
    const float* xsrc = (const float*)xsrc_; const unsigned short* xh = (const unsigned short*)xsrc_;
    constexpr bool PREG = !XF;
    constexpr int NR = XF ? 8 : 4;
#define NP_EOFF(j_) (512 * ((j_) >> 1) + 4 * ((j_) & 1))
#define NP_LDR(dst_, r_) do { _Pragma("unroll") for (int q_ = 0; q_ < NR; ++q_) { \
        if constexpr (XF) dst_[q_] = __builtin_bit_cast(v4u, *(const GAS f32x4*)(xsrc + (size_t)(r_) * DM + NP_EOFF(q_) + 8 * lane)); \
        else dst_[q_] = *(const GAS v4u*)(xh + (size_t)(r_) * DM + 512 * q_ + 8 * lane); } } while (0)
#define NP_CVT(y_, src_) do { _Pragma("unroll") for (int q_ = 0; q_ < NR; ++q_) { \
        if constexpr (XF) y_[q_] = __builtin_bit_cast(f32x4, src_[q_]); \
        else { const v4u w_ = src_[q_]; y_[2 * q_] = (f32x4){h_lo(w_.x), h_hi(w_.x), h_lo(w_.y), h_hi(w_.y)}; y_[2 * q_ + 1] = (f32x4){h_lo(w_.z), h_hi(w_.z), h_lo(w_.w), h_hi(w_.w)}; } } } while (0)
    const int tid = F.tid, lane = F.lane, wave = F.wave;
    if constexpr (NG > 0) {
        for (int i = tid; i < NG * 512; i += NTHREADS) { const int g = i >> 9, d = i & 511, j = d >> 6, ln = d & 63;
            ((LAS f32x4*)F.lds)[i] = ((const GAS f32x4*)Wg)[g * 512 + 128 * (j >> 1) + 2 * ln + (j & 1)]; }
        __syncthreads();
    }
    bf16* H = (bf16*)(F.ka->ws + WS_H); float* gpre = (float*)(F.ka->ws + WS_GPRE);
    const int gw = F.bid * NWAVES + wave, rows_per = MROWS / (GRID * NWAVES);
    const int row0 = gw * rows_per, b = row0 / SEQ;
    const float* scp = mod_l + (size_t)b * MODW + sc_off + 8 * lane; const float* shp = mod_l + (size_t)b * MODW + sh_off + 8 * lane; const float* nwp = nw + 8 * lane;
    f32x4 y0[8], y1[8];
    { v4u f0[NR], f1[NR]; NP_LDR(f0, row0); NP_LDR(f1, row0 + 1); NP_CVT(y0, f0); NP_CVT(y1, f1); }
    f32x4 pav[PREG ? 8 : 1], shv[PREG ? 8 : 1];
    if constexpr (PREG) {
#pragma unroll
        for (int j = 0; j < 8; ++j) { const f32x4 w = *(const GAS f32x4*)(nwp + NP_EOFF(j)), sc = *(const GAS f32x4*)(scp + NP_EOFF(j)); pav[j] = w * (sc + 1.0f); shv[j] = *(const GAS f32x4*)(shp + NP_EOFF(j)); } }
    for (int rp = 0; rp < rows_per; rp += 2) {
        const int r0 = row0 + rp;
        if constexpr (!PREG) asm volatile("" : "+v"(scp), "+v"(shp), "+v"(nwp));
        const int rn = (rp + 2 < rows_per) ? r0 + 2 : r0;
        v4u n0[NR], n1[NR];
        NP_LDR(n0, rn); NP_LDR(n1, rn + 1);
        float s0 = 0.f, s1 = 0.f;
#pragma unroll
        for (int j = 0; j < 8; ++j) { s0 += (y0[j].x * y0[j].x + y0[j].y * y0[j].y) + (y0[j].z * y0[j].z + y0[j].w * y0[j].w); s1 += (y1[j].x * y1[j].x + y1[j].y * y1[j].y) + (y1[j].z * y1[j].z + y1[j].w * y1[j].w); }
        s0 = wave_sum(s0); s1 = wave_sum(s1);
        const float rs0 = rsqrtf(s0 * (1.0f / DM) + EPS), rs1 = rsqrtf(s1 * (1.0f / DM) + EPS);
#pragma unroll
        for (int c = 0; c < 4; ++c) {
#pragma unroll
            for (int hh = 0; hh < 2; ++hh) { const int j = 2 * c + hh; f32x4 pa, sh;
                if constexpr (PREG) { pa = pav[j]; sh = shv[j]; }
                else { const f32x4 w = *(const GAS f32x4*)(nwp + NP_EOFF(j)), sc = *(const GAS f32x4*)(scp + NP_EOFF(j)); sh = *(const GAS f32x4*)(shp + NP_EOFF(j)); pa = w * (sc + 1.0f); }
                y0[j] = y0[j] * rs0 * pa + sh; y1[j] = y1[j] * rs1 * pa + sh; }
            v4u o0, o1; o0.x = pk2(y0[2 * c].x, y0[2 * c].y); o0.y = pk2(y0[2 * c].z, y0[2 * c].w); o0.z = pk2(y0[2 * c + 1].x, y0[2 * c + 1].y); o0.w = pk2(y0[2 * c + 1].z, y0[2 * c + 1].w);
            o1.x = pk2(y1[2 * c].x, y1[2 * c].y); o1.y = pk2(y1[2 * c].z, y1[2 * c].w); o1.z = pk2(y1[2 * c + 1].x, y1[2 * c + 1].y); o1.w = pk2(y1[2 * c + 1].z, y1[2 * c + 1].w);
            *(GAS v4u*)(H + (size_t)r0 * DM + 512 * c + 8 * lane) = o0; *(GAS v4u*)(H + (size_t)(r0 + 1) * DM + 512 * c + 8 * lane) = o1; }
        if constexpr (NG > 0) {
#pragma unroll 1
            for (int g0 = 0; g0 < NG; g0 += 2) {
                const LAS float* wl = (const LAS float*)F.lds + g0 * DM + 4 * lane;
                float t00 = 0.f, t01 = 0.f, t10 = 0.f, t11 = 0.f;
#pragma unroll
                for (int j = 0; j < 8; ++j) { const f32x4 wa = *(const LAS f32x4*)(wl + 256 * j), wb = *(const LAS f32x4*)(wl + DM + 256 * j);
                    t00 += (y0[j].x * wa.x + y0[j].y * wa.y) + (y0[j].z * wa.z + y0[j].w * wa.w); t01 += (y0[j].x * wb.x + y0[j].y * wb.y) + (y0[j].z * wb.z + y0[j].w * wb.w);
                    t10 += (y1[j].x * wa.x + y1[j].y * wa.y) + (y1[j].z * wa.z + y1[j].w * wa.w); t11 += (y1[j].x * wb.x + y1[j].y * wb.y) + (y1[j].z * wb.z + y1[j].w * wb.w); }
                t00 = wave_sum(t00); t01 = wave_sum(t01); t10 = wave_sum(t10); t11 = wave_sum(t11);
                if (lane == 0) { typedef float f32x2_t __attribute__((ext_vector_type(2)));
                    *(GAS f32x2_t*)(gpre + (size_t)g0 * MROWS + r0) = (f32x2_t){t00, t10}; *(GAS f32x2_t*)(gpre + (size_t)(g0 + 1) * MROWS + r0) = (f32x2_t){t01, t11}; }
            }
        }
        NP_CVT(y0, n0); NP_CVT(y1, n1);
    }
    if constexpr (NG > 0) __syncthreads();
#undef NP_EOFF
#undef NP_LDR
#undef NP_CVT
}

__device__ __forceinline__ float block_excl_sum(Frame& F, float tot, LAS float* scr) {
    float inc = tot;
#pragma unroll
    for (int o = 1; o < 64; o <<= 1) { const float t = __shfl_up(inc, o); if (F.lane >= o) inc += t; }
    if (F.lane == 63) scr[F.wave] = inc;
    __syncthreads();
    float base = 0.f;
    for (int w = 0; w < F.wave; ++w) base += scr[w];
    __syncthreads();
    return base + inc - tot;
}
__device__ __forceinline__ float block_excl_max(Frame& F, float tot, LAS float* scr) {
    float inc = tot;
#pragma unroll
    for (int o = 1; o < 64; o <<= 1) { const float t = __shfl_up(inc, o); if (F.lane >= o) inc = fmaxf(inc, t); }
    if (F.lane == 63) scr[F.wave] = inc;
    __syncthreads();
    float base = -__builtin_inff();
    for (int w = 0; w < F.wave; ++w) base = fmaxf(base, scr[w]);
    __syncthreads();
    const float prev = __shfl_up(inc, 1);
    return fmaxf(base, F.lane > 0 ? prev : -__builtin_inff());
}
__device__ __forceinline__ void mlstm_gate_scan(Frame& F, int bh, const float* bgates  ) {
    const int b = bh >> 2, h = bh & 3, t0 = F.tid * 16;
    const float* gpi = (const float*)(F.ka->ws + WS_GPRE) + (size_t)h * MROWS + (size_t)b * SEQ + t0;
    const float* gpf = gpi + (size_t)4 * MROWS;
    LAS float* scr = (LAS float*)F.lds;
    const float bi = bgates[h], bf = bgates[4 + h];
    float gI[16], gF[16];
#pragma unroll
    for (int q = 0; q < 4; ++q) { const f32x4 a = *(const GAS f32x4*)(gpi + 4 * q), c = *(const GAS f32x4*)(gpf + 4 * q);
        gI[4 * q] = a.x; gI[4 * q + 1] = a.y; gI[4 * q + 2] = a.z; gI[4 * q + 3] = a.w; gF[4 * q] = c.x; gF[4 * q + 1] = c.y; gF[4 * q + 2] = c.z; gF[4 * q + 3] = c.w; }
    float li[16], fc[16];
    float run = 0.f;
#pragma unroll
    for (int i = 0; i < 16; ++i) { const float gi = gI[i] + bi, gf = gF[i] + bf;
        li[i] = SOFTCAP * tanhf_(gi * (1.0f / SOFTCAP)); const float lf = logsigmoidf_(SOFTCAP * tanhf_(gf * (1.0f / SOFTCAP))); run += lf; fc[i] = run; }
    const float basef = block_excl_sum(F, run, scr);
    float am = -__builtin_inff(); float av[16];
#pragma unroll
    for (int i = 0; i < 16; ++i) { fc[i] += basef; av[i] = li[i] - fc[i]; am = fmaxf(am, av[i]); }
    float m = fmaxf(block_excl_max(F, am, scr), 0.f);
    float* SA = (float*)(F.ka->ws + WS_SA) + (size_t)bh * SEQ + t0; float* SM = (float*)(F.ka->ws + WS_SM) + (size_t)bh * SEQ + t0; float* SF = (float*)(F.ka->ws + WS_SF) + (size_t)bh * SEQ + t0;
#pragma unroll
    for (int i = 0; i < 16; ++i) { m = fmaxf(m, av[i]); SA[i] = av[i]; SM[i] = m; SF[i] = fc[i]; }
}
__device__ __forceinline__ void fox_gate_scan(Frame& F, int bh, const float* bfv  ) {
    const int b = bh >> 4, h = bh & 15, t0 = F.tid * 16;
    const float* gp = (const float*)(F.ka->ws + WS_GPRE) + (size_t)h * MROWS + (size_t)b * SEQ + t0;
    LAS float* scr = (LAS float*)F.lds;
    const float bb = bfv[h];
    float gv[16];
#pragma unroll
    for (int q = 0; q < 4; ++q) { const f32x4 a = *(const GAS f32x4*)(gp + 4 * q); gv[4 * q] = a.x; gv[4 * q + 1] = a.y; gv[4 * q + 2] = a.z; gv[4 * q + 3] = a.w; }
    float fc[16]; float run = 0.f;
#pragma unroll
    for (int i = 0; i < 16; ++i) { run += logsigmoidf_(gv[i] + bb); fc[i] = run; }
    const float basef = block_excl_sum(F, run, scr);
    float* NB = (float*)(F.ka->ws + WS_NB) + (size_t)bh * SEQ + t0;
#pragma unroll
    for (int i = 0; i < 16; ++i) NB[i] = -(fc[i] + basef) * (1.0f / SCALE_A);
}

struct MainSched {
    pg8::TileOrder T; const char* A; const char* B; char* O; size_t tA, tB, tOm, tOn;
    __device__ __forceinline__ bool next(int i, pg8::Unit& u) const { int pm, pn; if (!T.tile(i, pm, pn)) return false;
        u.pm = pm; u.pn = pn; u.A = A + (size_t)pm * tA; u.B = B + (size_t)pn * tB; u.A1 = nullptr; u.B1 = nullptr; u.O = O + (size_t)pm * tOm + (size_t)pn * tOn; return true; }
};
struct EpiStore {
    static constexpr bool PERM = true; int ldo; unsigned* kn;
    __device__ __forceinline__ void operator()(const pg8::f32x4 (&acc)[2][2][4][2], const pg8::Unit& u, int wr, int wc, int fr, int fq, PG8_LAS unsigned char* scr) const {
        if (kn != nullptr && u.pn >= 8 && u.pn < 16) {
            float km0 = 0.f, km1 = 0.f;
#pragma unroll
            for (int ai = 0; ai < 2; ++ai)
#pragma unroll
                for (int m = 0; m < 4; ++m) {
                    float s0 = 0.f, s1 = 0.f;
#pragma unroll
                    for (int n = 0; n < 2; ++n)
#pragma unroll
                        for (int e = 0; e < 4; ++e) { s0 = fmaf(acc[ai][0][m][n][e], acc[ai][0][m][n][e], s0); s1 = fmaf(acc[ai][1][m][n][e], acc[ai][1][m][n][e], s1); }
                    s0 += __shfl_xor(s0, 16); s1 += __shfl_xor(s1, 16); s0 += __shfl_xor(s0, 32); s1 += __shfl_xor(s1, 32);
                    km0 = fmaxf(km0, s0); km1 = fmaxf(km1, s1); }
#pragma unroll
            for (int o = 1; o < 16; o <<= 1) { km0 = fmaxf(km0, __shfl_xor(km0, o)); km1 = fmaxf(km1, __shfl_xor(km1, o)); }
            if (fq == 0 && fr == 0) { unsigned* kp = kn + (((u.pm >> 5) * 16 + 2 * (u.pn - 8)) * 4 + wc);
                atomicMax(kp, __float_as_uint(km0)); atomicMax(kp + 4, __float_as_uint(km1)); }
        }
        const int lane = fq * 16 + fr, rr = lane >> 2, ch = lane & 3;
        bf16* base = (bf16*)u.O + (size_t)(wr * 64 + rr) * ldo + wc * 32 + 8 * ch;
        PG8_LAS unsigned char* wp = scr + fr * 64 + ((fq ^ ((fr >> 1) & 3)) * 16);
        PG8_LAS unsigned char* rp = scr + rr * 64 + ((ch ^ ((rr >> 1) & 3)) * 16);
#pragma unroll
        for (int ai = 0; ai < 2; ++ai)
#pragma unroll
            for (int m = 0; m < 4; ++m) { bf16* rowp = base + (size_t)(ai * 128 + m * 16) * ldo;
#pragma unroll
                for (int bj = 0; bj < 2; ++bj) { const pg8::f32x4 v0 = acc[ai][bj][m][0], v1 = acc[ai][bj][m][1];
                    v4u w; w.x = pk2(v0[0], v0[1]); w.y = pk2(v0[2], v0[3]); w.z = pk2(v1[0], v1[1]); w.w = pk2(v1[2], v1[3]);
                    *(PG8_LAS v4u*)(wp + bj * 8192) = w;
                    const v4u t = *(const PG8_LAS v4u*)(rp + bj * 8192);
                    *(GAS v4u*)(rowp + bj * 128) = t; } }
    }
};
struct EpiSwiglu {
    static constexpr bool PERM = true;
    __device__ __forceinline__ void operator()(const pg8::f32x4 (&acc)[2][2][4][2], const pg8::Unit& u, int wr, int wc, int fr, int fq, PG8_LAS unsigned char* scr) const {
        const int lane = fq * 16 + fr, rr = lane >> 2, ch = lane & 3;
        bf16* base = (bf16*)u.O + (size_t)(wr * 64 + rr) * DFF + wc * 32 + 8 * ch;
        PG8_LAS unsigned char* wp = scr + fr * 64 + ((fq ^ ((fr >> 1) & 3)) * 16);
        PG8_LAS unsigned char* rp = scr + rr * 64 + ((ch ^ ((rr >> 1) & 3)) * 16);
#pragma unroll
        for (int ai = 0; ai < 2; ++ai)
#pragma unroll
            for (int m = 0; m < 4; ++m) { float r[8];
#pragma unroll
                for (int n = 0; n < 2; ++n)
#pragma unroll
                    for (int e = 0; e < 4; ++e) { const float g = acc[ai][0][m][n][e], up = acc[ai][1][m][n][e]; r[4 * n + e] = g * up * __builtin_amdgcn_rcpf(1.0f + __expf(-g)); }
                v4u w; w.x = pk2(r[0], r[1]); w.y = pk2(r[2], r[3]); w.z = pk2(r[4], r[5]); w.w = pk2(r[6], r[7]);
                *(PG8_LAS v4u*)(wp + (m & 1) * 8192) = w;
                const v4u t = *(const PG8_LAS v4u*)(rp + (m & 1) * 8192);
                *(GAS v4u*)(base + (size_t)(ai * 128 + m * 16) * DFF) = t; }
    }
};
template <bool XF, int AH = 2>
struct EpiResid {
    static constexpr bool PERM = true; const float* gate_l  ; const void* xin  ;
    static constexpr int AHEAD = XF ? 2 : AH, NB = (AHEAD == 8) ? 8 : 3;
    __device__ __forceinline__ void operator()(const pg8::f32x4 (&acc)[2][2][4][2], const pg8::Unit& u, int wr, int wc, int fr, int fq, PG8_LAS unsigned char* scr) const {
        const int b = u.pm >> 5;
        const int lane = fq * 16 + fr, rr = lane >> 2, c2 = lane & 3;
        const float* gp = gate_l + (size_t)b * MODW + u.pn * 256 + wc * 32 + 8 * fq;
        pg8::f32x4 gv[2][2];
#pragma unroll
        for (int bj = 0; bj < 2; ++bj) { gv[bj][0] = *(const GAS pg8::f32x4*)(gp + bj * 128); gv[bj][1] = *(const GAS pg8::f32x4*)(gp + bj * 128 + 4); }
        unsigned short* obase = (unsigned short*)u.O + (size_t)(wr * 64 + rr) * DM + wc * 32 + 8 * c2;
        const size_t eoff = (size_t)(u.pm * 256 + wr * 64 + rr) * DM + u.pn * 256 + wc * 32 + 8 * c2;
        PG8_LAS unsigned char* wp = scr + fr * 64 + ((fq ^ ((fr >> 1) & 3)) * 16);
        PG8_LAS unsigned char* rp = scr + rr * 64 + ((c2 ^ ((rr >> 1) & 3)) * 16);
        v4u xh[XF ? 1 : NB][2]; pg8::f32x4 xf[XF ? NB : 1][4];
#define ER_LOAD(g_) do { const size_t q_ = eoff + (size_t)(((g_) >> 2) * 128 + ((g_) & 3) * 16) * DM; \
            if constexpr (XF) { const float* f_ = (const float*)xin + q_; xf[(g_) % NB][0] = *(const GAS pg8::f32x4*)f_; xf[(g_) % NB][1] = *(const GAS pg8::f32x4*)(f_ + 4); \
                xf[(g_) % NB][2] = *(const GAS pg8::f32x4*)(f_ + 128); xf[(g_) % NB][3] = *(const GAS pg8::f32x4*)(f_ + 132); } \
            else { const unsigned short* h_ = (const unsigned short*)xin + q_; xh[(g_) % NB][0] = *(const GAS v4u*)h_; xh[(g_) % NB][1] = *(const GAS v4u*)(h_ + 128); } } while (0)
#pragma unroll
        for (int g = 0; g < AHEAD; ++g) ER_LOAD(g);
#pragma unroll
        for (int g = 0; g < 8; ++g) { const int ai = g >> 2, m = g & 3; unsigned short* p = obase + (size_t)(ai * 128 + m * 16) * DM;
            if (g + AHEAD < 8) ER_LOAD(g + AHEAD);
            v4u w[2], t[2];
#pragma unroll
            for (int bj = 0; bj < 2; ++bj) { const pg8::f32x4 i0 = gv[bj][0] * acc[ai][bj][m][0], i1 = gv[bj][1] * acc[ai][bj][m][1];
                w[bj].x = pkh2(i0[0], i0[1]); w[bj].y = pkh2(i0[2], i0[3]); w[bj].z = pkh2(i1[0], i1[1]); w[bj].w = pkh2(i1[2], i1[3]); }
            *(PG8_LAS v4u*)(wp) = w[0]; *(PG8_LAS v4u*)(wp + 8192) = w[1];
            t[0] = *(const PG8_LAS v4u*)(rp); t[1] = *(const PG8_LAS v4u*)(rp + 8192);
#pragma unroll
            for (int bj = 0; bj < 2; ++bj) {
                const unsigned t0_ = t[bj].x, t1_ = t[bj].y, t2_ = t[bj].z, t3_ = t[bj].w;
                const pg8::f32x4 da = (pg8::f32x4){h_lo(t0_), h_hi(t0_), h_lo(t1_), h_hi(t1_)}, db = (pg8::f32x4){h_lo(t2_), h_hi(t2_), h_lo(t3_), h_hi(t3_)};
                pg8::f32x4 xa, xb;
                if constexpr (XF) { xa = xf[g % NB][2 * bj]; xb = xf[g % NB][2 * bj + 1]; }
                else { const v4u xw = xh[g % NB][bj]; const unsigned x0_ = xw.x, x1_ = xw.y, x2_ = xw.z, x3_ = xw.w;
                    xa = (pg8::f32x4){h_lo(x0_), h_hi(x0_), h_lo(x1_), h_hi(x1_)}; xb = (pg8::f32x4){h_lo(x2_), h_hi(x2_), h_lo(x3_), h_hi(x3_)}; }
                const pg8::f32x4 ra = xa + da, rb = xb + db;
                v4u o; o.x = pkh2(ra[0], ra[1]); o.y = pkh2(ra[2], ra[3]); o.z = pkh2(rb[0], rb[1]); o.w = pkh2(rb[2], rb[3]);
                *(GAS v4u*)(p + bj * 128) = o;
            } }
#undef ER_LOAD
    }
};
struct SchedS {
    int G, c; const char* proj; char* P;
    __device__ __forceinline__ bool next(int i, pg8::Unit& u) const { const int L0 = i * G + c; if (L0 >= NCHH) return false;
        const int L = (L0 & 7) * (NCHH / 8) + (L0 >> 3);
        const int bh = L >> 5, cc = L & 31, b = bh >> 2, h = bh & 3; const size_t row0 = (size_t)b * SEQ + cc * LC;
        u.pm = L; u.pn = 0; u.A = proj + (row0 * NPROJ + h * DQK) * 2; u.B = proj + (row0 * NPROJ + 1024 + h * DQK) * 2; u.A1 = nullptr; u.B1 = nullptr; u.O = P + (size_t)L * LC * LC * 2; return true; }
};
struct EpiS {
    static constexpr bool PERM = true; const float* SA; const float* SM;
    __device__ __forceinline__ void operator()(const pg8::f32x4 (&acc)[2][2][4][2], const pg8::Unit& u, int wr, int wc, int fr, int fq, PG8_LAS unsigned char* scr) const {
        const float* sa = SA + (size_t)u.pm * LC; const float* sm = SM + (size_t)u.pm * LC;
        bf16* base = (bf16*)u.O + (size_t)(wr * 64 + fr) * LC + wc * 32 + 8 * fq;
        pg8::f32x4 av[2][2];
#pragma unroll
        for (int bj = 0; bj < 2; ++bj)
#pragma unroll
            for (int n = 0; n < 2; ++n) av[bj][n] = *(const GAS pg8::f32x4*)(sa + bj * 128 + wc * 32 + 8 * fq + 4 * n);
#pragma unroll
        for (int ai = 0; ai < 2; ++ai)
#pragma unroll
            for (int m = 0; m < 4; ++m) { const int t = ai * 128 + wr * 64 + m * 16 + fr; const float mt = sm[t];
#pragma unroll
                for (int bj = 0; bj < 2; ++bj) { float r[8];
#pragma unroll
                    for (int n = 0; n < 2; ++n)
#pragma unroll
                        for (int e = 0; e < 4; ++e) { const int s = bj * 128 + wc * 32 + 8 * fq + 4 * n + e;
                            r[4 * n + e] = (s <= t) ? SCALE_M * acc[ai][bj][m][n][e] * __expf(av[bj][n][e] - mt) : 0.f; }
                    v4u w; w.x = pk2(r[0], r[1]); w.y = pk2(r[2], r[3]); w.z = pk2(r[4], r[5]); w.w = pk2(r[6], r[7]);
                    *(GAS v4u*)(base + (size_t)(ai * 128 + m * 16) * LC + bj * 128) = w; } }
    }
};
struct SchedDC {
    int G, c; const char* VT; const char* KWT; char* CT;
    __device__ __forceinline__ bool next(int i, pg8::Unit& u) const { const int L0 = i * G + c; if (L0 >= 2 * NCHH) return false;
        const int L = (L0 & 7) * (2 * NCHH / 8) + (L0 >> 3);
        const int ch = L >> 1, half = L & 1;
        u.pm = ch; u.pn = half; u.A = VT + ((size_t)ch * DV + half * 256) * LC * 2; u.B = KWT + (size_t)ch * DQK * LC * 2; u.A1 = nullptr; u.B1 = nullptr; u.O = CT + ((size_t)ch * DV + half * 256) * DQK * 2; return true; }
};
struct SchedNum {
    int G, c; const char* proj; const char* CT; const char* P; const char* VT; char* Y;
    __device__ __forceinline__ bool next(int i, pg8::Unit& u) const { const int L0 = i * G + c; if (L0 >= 2 * NCHH) return false;
        const int L = (L0 & 7) * (2 * NCHH / 8) + (L0 >> 3);
        const int ch = L >> 1, half = L & 1, bh = ch >> 5, cc = ch & 31, b = bh >> 2, h = bh & 3; const size_t row0 = (size_t)b * SEQ + cc * LC;
        u.pm = ch; u.pn = half; u.A = proj + (row0 * NPROJ + h * DQK) * 2; u.B = CT + ((size_t)ch * DV + half * 256) * DQK * 2;
        u.A1 = P + (size_t)ch * LC * LC * 2; u.B1 = VT + ((size_t)ch * DV + half * 256) * LC * 2; u.O = Y + (row0 * DM + h * DV + half * 256) * 2; return true; }
};
struct EpiNum : EpiStore {
    const float* SM;
    __device__ __forceinline__ void mid(pg8::f32x4 (&acc)[2][2][4][2], const pg8::Unit& u, int wr, int wc, int fr, int fq, PG8_LAS unsigned char* scr) const {
        const float* sm = SM + (size_t)u.pm * LC; const float mc = (u.pm & 31) ? sm[-1] : 0.f;
#pragma unroll
        for (int ai = 0; ai < 2; ++ai)
#pragma unroll
            for (int m = 0; m < 4; ++m) { const float r = SCALE_M * __expf(mc - sm[ai * 128 + wr * 64 + m * 16 + fr]);
#pragma unroll
                for (int bj = 0; bj < 2; ++bj)
#pragma unroll
                    for (int n = 0; n < 2; ++n) acc[ai][bj][m][n] *= r; }
    }
};

#define MP_DECODE(it_, ch_, isK_, sb_, db_, src_, dst_) do { ch_ = (it_) / 48; const int r_ = (it_) % 48, bh_ = ch_ >> 5, cc_ = ch_ & 31, b_ = bh_ >> 2, h_ = bh_ & 3; \
        const size_t row0_ = (size_t)b_ * SEQ + cc_ * LC; isK_ = r_ < 16; int colbase_; \
        if (isK_) { sb_ = r_ >> 2; db_ = r_ & 3; colbase_ = 1024 + h_ * DQK + db_ * 64; dst_ = KWT + ((size_t)ch_ * DQK + db_ * 64) * LC + sb_ * 64; } \
        else { const int r2_ = r_ - 16; sb_ = r2_ >> 3; db_ = r2_ & 7; colbase_ = 2048 + h_ * DV + db_ * 64; dst_ = VT + ((size_t)ch_ * DV + db_ * 64) * LC + sb_ * 64; } \
        src_ = PROJ + (row0_ + sb_ * 64 + sr) * NPROJ + colbase_ + 8 * dc; } while (0)
#define MP_STAGE(v_, ch_, isK_, sb_, db_, dst_) do { const float mend_ = SM[(size_t)ch_ * LC + LC - 1]; \
        _Pragma("unroll") for (int i = 0; i < 8; ++i) { const int s_ = sr + 8 * i; const float w_ = isK_ ? __expf(SA[(size_t)ch_ * LC + sb_ * 64 + s_] - mend_) : 1.0f; \
            LAS float* d_ = scr + s_ * 65 + 8 * dc; \
            d_[0] = bf_lo(v_[i].x) * w_; d_[1] = bf_hi(v_[i].x) * w_; d_[2] = bf_lo(v_[i].y) * w_; d_[3] = bf_hi(v_[i].y) * w_; d_[4] = bf_lo(v_[i].z) * w_; d_[5] = bf_hi(v_[i].z) * w_; d_[6] = bf_lo(v_[i].w) * w_; d_[7] = bf_hi(v_[i].w) * w_; } \
        LDS_WAIT(); \
        if (isK_) { float a_ = 0.f; _Pragma("unroll 16") for (int s2_ = 0; s2_ < 64; ++s2_) a_ += scr[s2_ * 65 + lane]; DNP[((size_t)ch_ * 4 + sb_) * DQK + db_ * 64 + lane] = a_; } \
        tr_out(scr, dst_, LC, lane); } while (0)
__device__ __forceinline__ void mp_phase(Frame& F) {
    const int lane = F.lane;
    LAS float* scr = (LAS float*)(F.lds + F.wave * TR_SCR);
    const bf16* PROJ = (const bf16*)(F.ka->ws + WS_PROJ); bf16* KWT = (bf16*)(F.ka->ws + WS_KWT); bf16* VT = (bf16*)(F.ka->ws + WS_H);
    const float* SA = (const float*)(F.ka->ws + WS_SA); const float* SM = (const float*)(F.ka->ws + WS_SM); float* DNP = (float*)(F.ka->ws + WS_DNP);
    const int gw = F.bid * NWAVES + F.wave, NGW = GRID * NWAVES;
    const int dc = lane & 7, sr = lane >> 3;
    for (int it = gw; it < NCHH * 48; it += 2 * NGW) {
        const int it2 = it + NGW; const bool two = it2 < NCHH * 48;
        int chA, sbA, dbA, chB = 0, sbB = 0, dbB = 0; bool kA, kB = false; const bf16 *srcA, *srcB = nullptr; bf16 *dstA, *dstB = nullptr;
        MP_DECODE(it, chA, kA, sbA, dbA, srcA, dstA);
        if (two) MP_DECODE(it2, chB, kB, sbB, dbB, srcB, dstB);
        v4u va[8], vb[8];
#pragma unroll
        for (int i = 0; i < 8; ++i) va[i] = *(const GAS v4u*)(srcA + (size_t)(8 * i) * NPROJ);
        if (two) {
#pragma unroll
            for (int i = 0; i < 8; ++i) vb[i] = *(const GAS v4u*)(srcB + (size_t)(8 * i) * NPROJ); }
        MP_STAGE(va, chA, kA, sbA, dbA, dstA);
        if (two) MP_STAGE(vb, chB, kB, sbB, dbB, dstB);
    }
}
#undef MP_DECODE
#undef MP_STAGE
__device__ __forceinline__ void mc_phase(Frame& F) {
    const float* SM = (const float*)(F.ka->ws + WS_SM);
    const int gtid = F.bid * NTHREADS + F.tid, NT = GRID * NTHREADS;
    for (int idx = gtid; idx < NBH * 16384; idx += NT) {
        const int bh = idx >> 14, vec = idx & 16383;
        const GAS v4u* p = (const GAS v4u*)((const char*)F.ka->out) + (size_t)bh * NCH * 16384 + vec;
        GAS v4u* q = (GAS v4u*)((char*)F.ka->out + OUT_CT2) + (size_t)bh * NCH * 16384 + vec;
        const float* me = SM + (size_t)bh * SEQ + LC - 1;
        float st[8];
#pragma unroll
        for (int e = 0; e < 8; ++e) st[e] = 0.f;
        float mprev = 0.f;
        for (int c0 = 0; c0 < NCH; c0 += 8) {
            v4u x[8];
#pragma unroll
            for (int j = 0; j < 8; ++j) x[j] = p[(size_t)(c0 + j) * 16384];
#pragma unroll
            for (int j = 0; j < 8; ++j) { const float mcur = me[(size_t)(c0 + j) * LC]; const float dec = __expf(mprev - mcur); mprev = mcur;
                v4u o; o.x = pk2(st[0], st[1]); o.y = pk2(st[2], st[3]); o.z = pk2(st[4], st[5]); o.w = pk2(st[6], st[7]);
                q[(size_t)(c0 + j) * 16384] = o;
                st[0] = st[0] * dec + bf_lo(x[j].x); st[1] = st[1] * dec + bf_hi(x[j].x); st[2] = st[2] * dec + bf_lo(x[j].y); st[3] = st[3] * dec + bf_hi(x[j].y);
                st[4] = st[4] * dec + bf_lo(x[j].z); st[5] = st[5] * dec + bf_hi(x[j].z); st[6] = st[6] * dec + bf_lo(x[j].w); st[7] = st[7] * dec + bf_hi(x[j].w); }
        }
    }
    const float* DNP = (const float*)(F.ka->ws + WS_DNP); float* NST = (float*)(F.ka->ws + WS_NST);
    const int gw = F.bid * NWAVES + F.wave, NGW = GRID * NWAVES;
    for (int task = gw; task < NBH * DQK; task += NGW) {
        const int bh = task >> 8, d = task & 255, c = F.lane & 31, ch = bh * NCH + c;
        const float* dp = DNP + (size_t)ch * 4 * DQK + d;
        const float dn = (dp[0] + dp[DQK]) + (dp[2 * DQK] + dp[3 * DQK]);
        const float* me = SM + (size_t)bh * SEQ + LC - 1;
        float n = 0.f, mprev = 0.f, nout = 0.f;
#pragma unroll
        for (int cc = 0; cc < NCH; ++cc) { const float mcur = me[(size_t)cc * LC]; const float dec = __expf(mprev - mcur); mprev = mcur;
            const float dnc = __builtin_bit_cast(float, __builtin_amdgcn_readlane(__builtin_bit_cast(int, dn), cc));
            nout = (c == cc) ? n : nout; n = n * dec + dnc; }
        if (F.lane < NCH) NST[(size_t)ch * DQK + d] = nout;
    }
}
__device__ __forceinline__ void mn_phase(Frame& F, const float* mnw  ) {
    const int lane = F.lane;
    const bf16* Y = (const bf16*)(F.ka->ws + WS_Y); bf16* YO = (bf16*)(F.ka->ws + WS_H); const bf16* PROJ = (const bf16*)(F.ka->ws + WS_PROJ); const bf16* P = (const bf16*)(F.ka->ws + WS_P);
    const float* NST = (const float*)(F.ka->ws + WS_NST); const float* SM = (const float*)(F.ka->ws + WS_SM); const float* SF = (const float*)(F.ka->ws + WS_SF);
    const int gw = F.bid * NWAVES + F.wave, rows_per = MROWS / (GRID * NWAVES);
    f32x4 w0[MH], w1[MH];
#pragma unroll
    for (int h = 0; h < MH; ++h) { w0[h] = *(const GAS f32x4*)(mnw + h * DV + 8 * lane); w1[h] = *(const GAS f32x4*)(mnw + h * DV + 8 * lane + 4); }
    const int rowA = gw * rows_per, bW = rowA >> 13, ccW = (rowA & (SEQ - 1)) >> 8;
    f32x4 nn[MH]; float mc[MH];
#pragma unroll
    for (int h = 0; h < MH; ++h) { const int bh = bW * MH + h, ch = bh * NCH + ccW;
        nn[h] = *(const GAS f32x4*)(NST + (size_t)ch * DQK + 4 * lane); mc[h] = ccW ? SM[(size_t)bh * SEQ + ccW * LC - 1] : 0.f; }
    v4u nuN[MH], ogN[MH]; v2u ppN[MH], qqN[MH]; float mtN[MH], ftN[MH];
#define MN_LOAD(row_) do { const int t_ = (row_) & (SEQ - 1), tl_ = t_ & 255; _Pragma("unroll") for (int h = 0; h < MH; ++h) { const int bh = bW * MH + h, ch = bh * NCH + ccW; \
            nuN[h] = *(const GAS v4u*)(Y + (size_t)(row_) * DM + h * DV + 8 * lane); ogN[h] = *(const GAS v4u*)(PROJ + (size_t)(row_) * NPROJ + 4096 + h * DV + 8 * lane); \
            ppN[h] = *(const GAS v2u*)(P + ((size_t)ch * LC + tl_) * LC + 4 * lane); qqN[h] = *(const GAS v2u*)(PROJ + (size_t)(row_) * NPROJ + h * DQK + 4 * lane); \
            mtN[h] = SM[(size_t)bh * SEQ + t_]; ftN[h] = SF[(size_t)bh * SEQ + t_]; } } while (0)
    MN_LOAD(rowA);
    for (int row = rowA; row < rowA + rows_per; ++row) {
        v4u nu[MH], og[MH]; v2u pp[MH], qq[MH]; float mt[MH], ft[MH];
#pragma unroll
        for (int h = 0; h < MH; ++h) { nu[h] = nuN[h]; og[h] = ogN[h]; pp[h] = ppN[h]; qq[h] = qqN[h]; mt[h] = mtN[h]; ft[h] = ftN[h]; }
        { const int rn_ = (row + 1 < rowA + rows_per) ? row + 1 : row; MN_LOAD(rn_); }
#pragma unroll
        for (int h = 0; h < MH; ++h) {
            float nv[8] = {bf_lo(nu[h].x), bf_hi(nu[h].x), bf_lo(nu[h].y), bf_hi(nu[h].y), bf_lo(nu[h].z), bf_hi(nu[h].z), bf_lo(nu[h].w), bf_hi(nu[h].w)};
            float ov[8] = {bf_lo(og[h].x), bf_hi(og[h].x), bf_lo(og[h].y), bf_hi(og[h].y), bf_lo(og[h].z), bf_hi(og[h].z), bf_lo(og[h].w), bf_hi(og[h].w)};
            float ps = (bf_lo(pp[h].x) + bf_hi(pp[h].x)) + (bf_lo(pp[h].y) + bf_hi(pp[h].y));
            float qn = (bf_lo(qq[h].x) * nn[h].x + bf_hi(qq[h].x) * nn[h].y) + (bf_lo(qq[h].y) * nn[h].z + bf_hi(qq[h].y) * nn[h].w);
            float sq = 0.f;
#pragma unroll
            for (int e = 0; e < 8; ++e) sq += nv[e] * nv[e];
            ps = wave_sum(ps); qn = wave_sum(qn); sq = wave_sum(sq);
            const float den = ps + SCALE_M * __expf(mc[h] - mt[h]) * qn;
            const float hden = fmaxf(fabsf(den), __expf(-(ft[h] + mt[h])));
            const float inv = 1.0f / hden;
            const float rr = rsqrtf(sq * inv * inv * (1.0f / DV) + EPS) * inv;
            const float wv[8] = {w0[h].x, w0[h].y, w0[h].z, w0[h].w, w1[h].x, w1[h].y, w1[h].z, w1[h].w};
            float yv[8];
#pragma unroll
            for (int e = 0; e < 8; ++e) yv[e] = nv[e] * rr * wv[e] * sigmoidf_(ov[e]);
            v4u o; o.x = pk2(yv[0], yv[1]); o.y = pk2(yv[2], yv[3]); o.z = pk2(yv[4], yv[5]); o.w = pk2(yv[6], yv[7]);
            *(GAS v4u*)(YO + (size_t)row * DM + h * DV + 8 * lane) = o;
        }
    }
#undef MN_LOAD
}

__device__ __forceinline__ void attn_phase(Frame& F, const int jf, const int rep) {
    char* lds = (char*)F.lds;
    const fa::bf16* PROJ = (const fa::bf16*)(F.ka->ws + WS_PROJ); fa::bf16* Y = (fa::bf16*)(F.ka->ws + WS_Y); const float* NB = (const float*)(F.ka->ws + WS_NB);
    constexpr int NQB = SEQ / fa::QB, TOTAL = NQB * BATCH * FH;
    static_assert(GRID <= TOTAL, "every workgroup owns a first item");
    unsigned* ctr = (unsigned*)(F.ka->ws + WS_CTL) + CW_Q + jf * 2 + rep;
    unsigned* kn = (unsigned*)(F.ka->ws + WS_CTL) + CW_KN + jf * 256;
    volatile LAS unsigned* MISC = (volatile LAS unsigned*)(F.lds + MISC_OFF);
#define FA_DECODE(I_, bh_, qb_) do { qb_ = NQB - 1 - ((I_) >> 6); bh_ = (I_) & 63; } while (0)
#define FA_REF(r_, bh_, qb_) do { const int b_ = (bh_) >> 4, h_ = (bh_) & 15; const size_t rb_ = (size_t)b_ * SEQ; \
        r_.Q = PROJ + (rb_ + (size_t)(qb_) * fa::QB) * NPROJ + h_ * 128; r_.K = PROJ + rb_ * NPROJ + 2048 + h_ * 128; r_.V = PROJ + rb_ * NPROJ + 4096 + h_ * 128; \
        r_.O = Y + (rb_ + (size_t)(qb_) * fa::QB) * DM + h_ * 128; r_.P0 = (qb_) * fa::QB; } while (0)
    int bh, qb; FA_DECODE(F.bid, bh, qb);
    fa::BlockRef cur; FA_REF(cur, bh, qb);
    fa::Seam S;
    fa::prime(cur, lds, S, F.tid);
    for (;;) {
        float k2 = 0.f;
        {
            int tb = F.tid; asm volatile("" : "+v"(tb));
            const GAS f32x4* src = (const GAS f32x4*)(NB + (size_t)bh * SEQ);
            LAS f32x4* dstb = (LAS f32x4*)(F.lds + fa::BIAS_OFF);
#pragma unroll
            for (int i = 0; i < 4; ++i) dstb[tb + i * NTHREADS] = src[tb + i * NTHREADS];
            if (tb == 0) MISC[32] = (unsigned)GRID + atomicAdd(ctr, 1u);
            const int rowq = cur.P0 + (tb >> 6) * fa::QBLK + (tb & 31);
            const GAS unsigned char* kr = (const GAS unsigned char*)cur.K + (size_t)rowq * (NPROJ * 2) + ((tb >> 5) & 1) * 16;
            const float nbi = *(const GAS float*)(NB + (size_t)bh * SEQ + rowq);
            float ss = 0.f, dd = 0.f;
#pragma unroll
            for (int d0 = 0; d0 < 8; ++d0) { const v4u w = *reinterpret_cast<const v4u*>(&S.qr[d0]); const v4u kw = *(const GAS v4u*)(kr + d0 * 32);
#pragma unroll
                for (int e = 0; e < 4; ++e) { const float lo = bf_lo(w[e]), hi = bf_hi(w[e]); ss = fmaf(lo, lo, ss); ss = fmaf(hi, hi, ss);
                    dd = fmaf(lo, bf_lo(kw[e]), dd); dd = fmaf(hi, bf_hi(kw[e]), dd); } }
            ss += __shfl_xor(ss, 32); dd += __shfl_xor(dd, 32);
            float vi = dd + nbi;
#pragma unroll
            for (int o = 1; o < 32; o <<= 1) { ss = fmaxf(ss, __shfl_xor(ss, o)); vi = fminf(vi, __shfl_xor(vi, o)); }
            if ((tb & 63) == 0) { MISC[40 + (tb >> 6)] = __float_as_uint(ss); MISC[48 + (tb >> 6)] = __float_as_uint(vi); }
#pragma unroll
            for (int w = 0; w < 4; ++w) k2 += __uint_as_float(__hip_atomic_load(kn + bh * 4 + w, RLX_AGENT));
            fa::head_issue(cur, lds, S, tb);
        }
        __syncthreads();
        const int nidx = __builtin_amdgcn_readfirstlane((int)MISC[32]);
        int T0;
        {
            float q2 = 0.f, vmin = __uint_as_float(MISC[48]);
#pragma unroll
            for (int w = 0; w < NWAVES; ++w) { q2 = fmaxf(q2, __uint_as_float(MISC[40 + w])); vmin = fminf(vmin, __uint_as_float(MISC[48 + w])); }
            const float TH = 1.02f * __builtin_sqrtf(q2 * k2) + (fa::THR / fa::SCALE + 128.0f / (1.4426950408889634f * fa::SCALE) + 2.0f);
            const LAS float* bl = (const LAS float*)(F.lds + fa::BIAS_OFF);
            const int ln = fa::lane_now(), NTL = (cur.P0 >> 6);
            const bool live0 = !(ln < NTL && vmin - bl[64 * ln + 63] > TH), live1 = !(ln + 64 < NTL && vmin - bl[64 * ln + 64 * 64 + 63] > TH);
            const unsigned long long b0 = __ballot(live0), b1 = __ballot(live1);
            T0 = b0 ? __builtin_ctzll(b0) : 64 + __builtin_ctzll(b1);
            T0 = __builtin_amdgcn_readfirstlane(T0);
        }
        const bool last = nidx >= TOTAL;
        int bhn = bh, qbn = qb;
        fa::BlockRef nxt; if (last) nxt = cur; else { FA_DECODE(nidx, bhn, qbn); FA_REF(nxt, bhn, qbn); }
        fa::block(cur, nxt, lds, S, F.tid, T0);
        if (last) break;
        cur = nxt; bh = bhn; qb = qbn;
    }
#undef FA_DECODE
#undef FA_REF
}

__device__ __forceinline__ void final_norm_phase(Frame& F) {
    const int lane = F.lane;
    const int gw = F.bid * NWAVES + F.wave, rows_per = MROWS / (GRID * NWAVES);
    f32x4 pw[8];
#pragma unroll
    for (int j = 0; j < 8; ++j) pw[j] = *(const GAS f32x4*)(F.ka->in[15] + 256 * j + 4 * lane);
    const unsigned short* X = (const unsigned short*)(F.ka->ws + WS_X);
    const int rA = gw * rows_per, rE = rA + rows_per;
    v2u a[8], b[8];
#pragma unroll
    for (int j = 0; j < 8; ++j) { a[j] = *(const GAS v2u*)(X + (size_t)rA * DM + 256 * j + 4 * lane); b[j] = *(const GAS v2u*)(X + (size_t)(rA + 1) * DM + 256 * j + 4 * lane); }
    for (int r = rA; r < rE; ++r) {
        const int rn = (r + 2 < rE) ? r + 2 : rE - 1;
        v2u c[8];
#pragma unroll
        for (int j = 0; j < 8; ++j) c[j] = *(const GAS v2u*)(X + (size_t)rn * DM + 256 * j + 4 * lane);
        f32x4 y[8]; float s = 0.f;
#pragma unroll
        for (int j = 0; j < 8; ++j) { y[j] = unpk_h4(a[j]); s += (y[j].x * y[j].x + y[j].y * y[j].y) + (y[j].z * y[j].z + y[j].w * y[j].w); }
        const float rs = rsqrtf(wave_sum(s) * (1.0f / DM) + EPS);
#pragma unroll
        for (int j = 0; j < 8; ++j) *(GAS f32x4*)(F.ka->out + (size_t)r * DM + 256 * j + 4 * lane) = y[j] * rs * pw[j];
#pragma unroll
        for (int j = 0; j < 8; ++j) { a[j] = b[j]; b[j] = c[j]; }
    }
}
#ifndef G4_AH
#define G4_AH 8
#endif
#ifndef G2_AH
#define G2_AH 8
#endif
#ifndef G3_WGM
#define G3_WGM 4
#endif
#ifndef WGM_RES
#define WGM_RES 4
#endif
constexpr int PH_PER_LAYER = 11, PH_FINAL = 1 + DEPTH * PH_PER_LAYER, PH_END = PH_FINAL + 1;
__global__ void __launch_bounds__(NTHREADS, 2) fwd(Args args) {
    extern __shared__ __attribute__((aligned(16))) unsigned char lds[];
    Frame F;
    F.lds = (LAS unsigned char*)lds;
    F.wave0 = __builtin_amdgcn_readfirstlane((int)threadIdx.x >> 6); refresh(F);
    volatile LAS unsigned* MISC = (volatile LAS unsigned*)(F.lds + MISC_OFF);
    for (int u = F.tid; u < 256; u += NTHREADS) MISC[u] = 0u;
    __syncthreads();
    XcdBarrier bar = xcd_barrier_post((unsigned*)(F.ka->ws + WS_CTL) + CW_BAR + args.li * XCD_BAR_WORDS, MISC + 8);
#ifndef PH_MASK
#define PH_MASK 0xFFFFFFFFu
#endif
#define EN(n) ((PH_MASK >> (n)) & 1u)
#ifndef REP_MASK
#define REP_MASK 0u
#endif
#define PHASE_BEGIN(n) _Pragma("unroll 1") for (int rep = 0; rep < (((REP_MASK >> (n)) & 1u) ? 2 : 1); ++rep) { if (rep) xcd_barrier(bar); refresh(F);
#define PHASE_END }
#define IN(k) (F.ka->ph_lo <= (k) && (k) < F.ka->ph_hi)
#define WS (F.ka->ws)
#define OUT (F.ka->out)
#define AIN(k) (F.ka->in[k])
#define SEAM(k, k2) do { if (IN(k) && IN(k2)) xcd_barrier(bar); } while (0)

    PHASE_BEGIN(0) if (EN(0) && IN(0)) { p0_prologue(F); } PHASE_END
    SEAM(0, 1);

    for (int l = 0; l < DEPTH; ++l) {
        const int pb = 1 + PH_PER_LAYER * l, j = l >> 1; const bool isM = (l & 1) == 0;
#define MOD_L ((const float*)(WS + WS_MOD) + (size_t)l * BATCH * MODW)
#define X16 ((char*)(WS + WS_X))
#define X16B ((char*)(WS + WS_X2))
#define Hb ((const char*)(WS + WS_H))
#define PROJb ((const char*)(WS + WS_PROJ))
#define Yb ((const char*)(WS + WS_Y))

        PHASE_BEGIN(1) if (EN(1) && IN(pb + 0)) {
            if (l == 0) norm_phase<8, true>(F, AIN(0), AIN(4) + (size_t)l * DM, MOD_L, 0, DM, (const float*)(WS + WS_WG) + (size_t)j * 8 * DM);
            else if (isM) norm_phase<8, false>(F, X16, AIN(4) + (size_t)l * DM, MOD_L, 0, DM, (const float*)(WS + WS_WG) + (size_t)j * 8 * DM);
            else norm_phase<16, false>(F, X16, AIN(4) + (size_t)l * DM, MOD_L, 0, DM, (const float*)(WS + WS_WGF) + (size_t)j * 16 * DM);
        } PHASE_END
        SEAM(pb + 0, pb + 1);

        PHASE_BEGIN(2) if (EN(2) && IN(pb + 1)) {
            if (isM) { if (F.bid < NBH) mlstm_gate_scan(F, F.bid, AIN(7) + j * 8); }
            else { if (F.bid < BATCH * FH) fox_gate_scan(F, F.bid, AIN(11) + j * 16); }
            __syncthreads();
            pg8::Gemm g{(unsigned)(DM * 2), (unsigned)(DM * 2), 0u, 0u, DM, 0};
            MainSched S; S.T.init(MROWS, NPROJ, GRID, F.bid); S.A = Hb;
            S.B = isM ? (const char*)(WS + WS_WINM) + (size_t)j * NPROJ * DM * 2 : (const char*)(WS + WS_WINF) + (size_t)j * NPROJ * DM * 2;
            S.O = (char*)(WS + WS_PROJ); S.tA = (size_t)256 * DM * 2; S.tB = (size_t)256 * DM * 2; S.tOm = (size_t)256 * NPROJ * 2; S.tOn = 256 * 2;
            EpiStore E; E.ldo = NPROJ; E.kn = isM ? nullptr : (unsigned*)(WS + WS_CTL) + CW_KN + j * 256;
            pg8::gemm_phase<EpiStore, MainSched, true, true, false>(F.lds, g, S, E, F.tid);
        } PHASE_END
        SEAM(pb + 1, pb + 2);

        if (isM) {
            PHASE_BEGIN(3) if (EN(3) && IN(pb + 2)) { mp_phase(F); } PHASE_END
            SEAM(pb + 2, pb + 3);
            PHASE_BEGIN(4) if (EN(4) && IN(pb + 3)) {
                { pg8::Gemm g{(unsigned)(NPROJ * 2), (unsigned)(NPROJ * 2), 0u, 0u, DQK, 0};
                  SchedS S; S.G = GRID; S.c = F.bid; S.proj = PROJb; S.P = (char*)(WS + WS_P);
                  EpiS E; E.SA = (const float*)(WS + WS_SA); E.SM = (const float*)(WS + WS_SM);
                  pg8::gemm_phase<EpiS, SchedS, true, true, false>(F.lds, g, S, E, F.tid); }
                { pg8::Gemm g{(unsigned)(LC * 2), (unsigned)(LC * 2), 0u, 0u, LC, 0};
                  SchedDC S; S.G = GRID; S.c = F.bid; S.VT = Hb; S.KWT = (const char*)(WS + WS_KWT); S.CT = (char*)OUT;
                  EpiStore E; E.ldo = DQK; E.kn = nullptr;
                  pg8::gemm_phase<EpiStore, SchedDC, true, true, false>(F.lds, g, S, E, F.tid); }
            } PHASE_END
            SEAM(pb + 3, pb + 4);
            PHASE_BEGIN(5) if (EN(5) && IN(pb + 4)) { mc_phase(F); } PHASE_END
            SEAM(pb + 4, pb + 5);
            PHASE_BEGIN(6) if (EN(6) && IN(pb + 5)) {
                pg8::Gemm g{(unsigned)(NPROJ * 2), (unsigned)(DQK * 2), (unsigned)(LC * 2), (unsigned)(LC * 2), DQK + LC, DQK / 64};
                SchedNum S; S.G = GRID; S.c = F.bid; S.proj = PROJb; S.CT = (const char*)OUT + OUT_CT2; S.P = (const char*)(WS + WS_P); S.VT = Hb; S.Y = (char*)(WS + WS_Y);
                EpiNum E; E.ldo = DM; E.SM = (const float*)(WS + WS_SM);
                pg8::gemm_phase<EpiNum, SchedNum, true, true, true>(F.lds, g, S, E, F.tid);
            } PHASE_END
            SEAM(pb + 5, pb + 6);
            PHASE_BEGIN(7) if (EN(7) && IN(pb + 6)) { mn_phase(F, AIN(8) + (size_t)j * DM); } PHASE_END
            SEAM(pb + 6, pb + 7);
        } else {
            PHASE_BEGIN(8) if (EN(8) && IN(pb + 2)) { attn_phase(F, j, rep); } PHASE_END
            SEAM(pb + 2, pb + 7);
        }

        PHASE_BEGIN(9) if (EN(9) && IN(pb + 7)) {
            pg8::Gemm g{(unsigned)(DM * 2), (unsigned)(DM * 2), 0u, 0u, DM, 0};
            MainSched S; S.T.init(MROWS, DM, GRID, F.bid, WGM_RES); S.A = isM ? Hb : Yb;
            S.B = isM ? (const char*)(WS + WS_WOUTM) + (size_t)j * DM * DM * 2 : (const char*)(WS + WS_WOUTF) + (size_t)j * DM * DM * 2;
            S.O = rep ? (char*)(WS + WS_KWT) : X16B; S.tA = (size_t)256 * DM * 2; S.tB = (size_t)256 * DM * 2; S.tOm = (size_t)256 * DM * 2; S.tOn = 256 * 2;
            if (l == 0 && !rep) { EpiResid<true> E; E.gate_l = MOD_L + 2 * DM; E.xin = AIN(0); pg8::gemm_phase<EpiResid<true>, MainSched, true, true, false>(F.lds, g, S, E, F.tid); }
            else { EpiResid<false, G2_AH> E; E.gate_l = MOD_L + 2 * DM; E.xin = X16; pg8::gemm_phase<EpiResid<false, G2_AH>, MainSched, true, true, false>(F.lds, g, S, E, F.tid); }
        } PHASE_END
        SEAM(pb + 7, pb + 8);

        PHASE_BEGIN(10) if (EN(10) && IN(pb + 8)) { norm_phase<0, false>(F, X16B, AIN(5) + (size_t)l * DM, MOD_L, 3 * DM, 4 * DM, nullptr); } PHASE_END
        SEAM(pb + 8, pb + 9);

        PHASE_BEGIN(11) if (EN(11) && IN(pb + 9)) {
            pg8::Gemm g{(unsigned)(DM * 2), (unsigned)(DM * 2), 0u, 0u, DM, 0};
            MainSched S; S.T.init(MROWS, 2 * DFF, GRID, F.bid, G3_WGM); S.A = Hb; S.B = (const char*)(WS + WS_WGU) + (size_t)l * 2 * DFF * DM * 2;
            S.O = (char*)(WS + WS_PROJ); S.tA = (size_t)256 * DM * 2; S.tB = (size_t)256 * DM * 2; S.tOm = (size_t)256 * DFF * 2; S.tOn = 128 * 2;
            EpiSwiglu E;
            pg8::gemm_phase<EpiSwiglu, MainSched, true, true, false>(F.lds, g, S, E, F.tid);
        } PHASE_END
        SEAM(pb + 9, pb + 10);

        PHASE_BEGIN(12) if (EN(12) && IN(pb + 10)) {
            pg8::Gemm g{(unsigned)(DFF * 2), (unsigned)(DFF * 2), 0u, 0u, DFF, 0};
            MainSched S; S.T.init(MROWS, DM, GRID, F.bid, WGM_RES, 1); S.A = PROJb; S.B = (const char*)(WS + WS_WDN) + (size_t)l * DM * DFF * 2;
            S.O = rep ? (char*)(WS + WS_KWT) : X16; S.tA = (size_t)256 * DFF * 2; S.tB = (size_t)256 * DFF * 2; S.tOm = (size_t)256 * DM * 2; S.tOn = 256 * 2;
            EpiResid<false, G4_AH> E; E.gate_l = MOD_L + 5 * DM; E.xin = X16B;
            pg8::gemm_phase<EpiResid<false, G4_AH>, MainSched, true, true, false>(F.lds, g, S, E, F.tid);
        } PHASE_END
        SEAM(pb + 10, pb + 11);
    }

    PHASE_BEGIN(13) if (EN(13) && IN(PH_FINAL)) { final_norm_phase(F); } PHASE_END
#undef IN
#undef WS
#undef OUT
#undef AIN
#undef MOD_L
#undef X16
#undef X16B
#undef Hb
#undef PROJb
#undef Yb
#undef SEAM
}

#ifndef MK_CUTS
#define MK_CUTS {0, PH_END}
#endif
extern "C" void kernel_launch(void* const* d_in, const int* in_sizes, int n_in, void* d_out, int out_size, void* d_ws, size_t ws_size, hipStream_t stream) {
    static int grid = 0;
    if (grid == 0) {
        if (n_in != 16 || in_sizes[0] != MROWS * DM || out_size != MROWS * DM || ws_size < WS_END) {
            fprintf(stderr, "kernel_launch: shape/workspace mismatch (n_in %d, in0 %d, out %d, ws %zu, need %zu); nothing launched\n", n_in, n_in > 0 ? in_sizes[0] : -1, out_size, ws_size, (size_t)WS_END); grid = -1; return; }
        int dev = 0, cus = 0, per_cu = 0;
        if (hipGetDevice(&dev) != hipSuccess || hipDeviceGetAttribute(&cus, hipDeviceAttributeMultiprocessorCount, dev) != hipSuccess) { grid = -1; return; }
        if (hipFuncSetAttribute((const void*)fwd, hipFuncAttributeMaxDynamicSharedMemorySize, LDS_BYTES) != hipSuccess) { fprintf(stderr, "kernel_launch: hipFuncSetAttribute failed\n"); grid = -1; return; }
        if (hipOccupancyMaxActiveBlocksPerMultiprocessor(&per_cu, (const void*)fwd, NTHREADS, LDS_BYTES) != hipSuccess || per_cu < 1) { fprintf(stderr, "kernel_launch: occupancy query says %d\n", per_cu); (void)hipGetLastError(); }
        if (cus != 256) { fprintf(stderr, "kernel_launch: built for 256 CUs, device has %d; nothing launched\n", cus); grid = -1; return; }
        grid = GRID;
    }
    if (grid < 0) return;
    if (hipMemsetAsync((char*)d_ws + WS_CTL, 0, CTL_ZERO_BYTES, stream) != hipSuccess) return;
    Args a{};
    for (int i = 0; i < 16; ++i) a.in[i] = (const float*)d_in[i];
    a.out = (float*)d_out; a.ws = (unsigned char*)d_ws; a.pad = 0;
    const int cuts[] = MK_CUTS; constexpr int ncut = sizeof(cuts) / sizeof(int);
    for (int li = 0; li + 1 < ncut; ++li) {
        a.ph_lo = cuts[li]; a.ph_hi = cuts[li + 1]; a.li = li;
        hipLaunchKernelGGL(fwd, dim3(grid), dim3(NTHREADS), LDS_BYTES, stream, a);
        const hipError_t le = hipPeekAtLastError();
        if (le != hipSuccess) { fprintf(stderr, "kernel_launch: launch %d failed: %s\n", li, hipGetErrorName(le)); break; }
    }
}
```
